# Optimizing an MI355X kernel written in HIP

```python
import jax, jax.numpy as jnp
from jax import lax
import numpy as np

D_MODEL = 2048
BATCH = 16
SEQ = 256
DEPTH = 2
DEC_BATCH = 2
DEC_SEQ = 4096
PAST_LEN = 256

F32 = jnp.float32
GRID_W = 64
ATT_HEAD_DIM = 128
ATT_HEADS = (D_MODEL // 2) // ATT_HEAD_DIM
ATT_KV_HEADS = ATT_HEADS // 4
ATT_GROUP = ATT_HEADS // ATT_KV_HEADS
ATT_WIDTH = ATT_HEADS * ATT_HEAD_DIM
ATT_QBLOCK = 128
ROPE_THETA = 10000.0
RET_DK = 128
RET_DV = 128
RET_HEADS = (D_MODEL // 4) // RET_DV
RET_WIDTH = RET_HEADS * RET_DV
RET_CHUNK = 128
GLA_DK = 64
GLA_DV = 128
GLA_HEADS = (D_MODEL // 4) // GLA_DV
GLA_WIDTH = GLA_HEADS * GLA_DV
GLA_GATE_RANK = 16
GLA_TAU = 16.0
GLA_CHUNK = 64
MIX_WIDTH = ATT_WIDTH + RET_WIDTH + GLA_WIDTH
PROJ_SIZES = (ATT_WIDTH, ATT_KV_HEADS * ATT_HEAD_DIM, ATT_KV_HEADS * ATT_HEAD_DIM,
              RET_HEADS * RET_DK, RET_HEADS * RET_DK, RET_WIDTH, RET_WIDTH,
              GLA_HEADS * GLA_DK, GLA_HEADS * GLA_DK, GLA_WIDTH, GLA_WIDTH, 2 * GLA_GATE_RANK)
PROJ_COLS = sum(PROJ_SIZES)
D_FF = 5632
N_MOD = 9
MACARON_WEIGHT = 0.5
DEEPNORM_ALPHA = (2 * DEPTH) ** 0.25
DEEPNORM_BETA = (8 * DEPTH) ** -0.25
LN_EPS = 1e-5
RMS_EPS = 1e-6

kernel_name = 'hybrid_diffusion_prefix_step'


def layer_norm(x, g, b):
    xf = x.astype(F32)
    mu = jnp.mean(xf, axis=-1, keepdims=True)
    var = jnp.mean(jnp.square(xf - mu), axis=-1, keepdims=True)
    return ((xf - mu) * lax.rsqrt(var + LN_EPS) * g + b).astype(x.dtype)


def rms_norm(x, g):
    xf = x.astype(F32)
    y = xf * lax.rsqrt(jnp.mean(jnp.square(xf), axis=-1, keepdims=True) + RMS_EPS)
    return (y * g).astype(x.dtype)


def head_group_norm(x):
    xf = x.astype(F32)
    mu = jnp.mean(xf, axis=-1, keepdims=True)
    var = jnp.mean(jnp.square(xf - mu), axis=-1, keepdims=True)
    return (xf - mu) * lax.rsqrt(var + LN_EPS)


def modulate(x, shift, scale):
    return x * (1.0 + scale) + shift


def swiglu_ffn(u, w_in, w_out):
    gate, up = jnp.split(u @ w_in, 2, axis=-1)
    return (jax.nn.silu(gate) * up) @ w_out


def axial_rope_tables(rows):
    row = jnp.repeat(jnp.arange(rows, dtype=F32), GRID_W)
    col = jnp.tile(jnp.arange(GRID_W, dtype=F32), rows)
    n_freq = ATT_HEAD_DIM // 4
    inv = ROPE_THETA ** (-jnp.arange(n_freq, dtype=F32) / n_freq)
    ang = jnp.concatenate([row[:, None] * inv, col[:, None] * inv], axis=-1)
    return jnp.cos(ang), jnp.sin(ang)


def apply_rope(x, cos, sin):
    xf = x.astype(F32).reshape(*x.shape[:-1], x.shape[-1] // 2, 2)
    x1, x2 = xf[..., 0], xf[..., 1]
    c = cos[None, :, None, :]
    s = sin[None, :, None, :]
    return jnp.stack([x1 * c - x2 * s, x1 * s + x2 * c], axis=-1).reshape(x.shape).astype(x.dtype)


def blocked_attention(q, k, v):
    B, S, KV, G, HD = q.shape
    nb = S // ATT_QBLOCK
    qb = q.reshape(B, nb, ATT_QBLOCK, KV, G, HD).swapaxes(0, 1)
    scale = HD ** -0.5

    def block(qblk):
        s = jnp.einsum('bqkgd,btkd->bkgqt', qblk, k).astype(F32) * scale
        p = jax.nn.softmax(s, axis=-1).astype(v.dtype)
        return jnp.einsum('bkgqt,btkd->bqkgd', p, v)

    out = lax.map(block, qb)
    return out.swapaxes(0, 1).reshape(B, S, KV * G * HD)


def retention_chunkwise(q, k, v, log_gamma, s0):
    B, S, H, DK = q.shape
    DV = v.shape[-1]
    C = RET_CHUNK
    n = S // C
    q = q.reshape(B, n, C, H, DK)
    k = k.reshape(B, n, C, H, DK)
    v = v.reshape(B, n, C, H, DV)
    idx = jnp.arange(C, dtype=F32)
    diff = idx[:, None] - idx[None, :]
    dmat = jnp.where(diff >= 0, jnp.exp(jnp.maximum(diff, 0.0)[None] * log_gamma[:, None, None]), 0.0)
    scores = jnp.einsum('bnihd,bnjhd->bnhij', q, k) * dmat
    intra = jnp.einsum('bnhij,bnjhe->bnihe', scores, v)
    k_dec = k * jnp.exp((C - 1 - idx)[:, None] * log_gamma[None, :])[:, :, None]
    kv = jnp.einsum('bnjhd,bnjhe->bnhde', k_dec, v)
    chunk_decay = jnp.exp(C * log_gamma)[None, :, None, None]

    def step(s, kv_c):
        return chunk_decay * s + kv_c, s

    s_final, s_prev = lax.scan(step, s0, kv.swapaxes(0, 1))
    q_dec = q * jnp.exp((idx + 1.0)[:, None] * log_gamma[None, :])[:, :, None]
    inter = jnp.einsum('bnihd,nbhde->bnihe', q_dec, s_prev)
    return (intra + inter).reshape(B, S, H, DV), s_final


def gla_chunkwise(q, k, v, log_a, s0):
    B, S, H, DK = q.shape
    DV = v.shape[-1]
    C = GLA_CHUNK
    n = S // C
    q = q.reshape(B, n, C, H, DK)
    k = k.reshape(B, n, C, H, DK)
    v = v.reshape(B, n, C, H, DV)
    b = jnp.cumsum(log_a.reshape(B, n, C, H, DK), axis=2)
    b_last = b[:, :, -1]
    q_t = q * jnp.exp(b)
    k_t = k * jnp.exp(-b)
    causal = jnp.tril(jnp.ones((C, C), F32))
    att = jnp.einsum('bnihd,bnjhd->bnhij', q_t, k_t) * causal
    intra = jnp.einsum('bnhij,bnjhe->bnihe', att, v)
    k_s = k * jnp.exp(b_last[:, :, None] - b)
    kv = jnp.einsum('bnjhd,bnjhe->bnhde', k_s, v)
    dec = jnp.exp(b_last)

    def step(s, inp):
        kv_c, dec_c = inp
        return dec_c[..., None] * s + kv_c, s

    s_final, s_prev = lax.scan(step, s0, (kv.swapaxes(0, 1), dec.swapaxes(0, 1)))
    inter = jnp.einsum('bnihd,nbhde->bnihe', q_t, s_prev)
    return (intra + inter).reshape(B, S, H, DV), s_final


def token_mixer(u, w_in, w_out, q_norm, k_norm, log_decay, w_a2, b_a, gla_norm, rope, ctx):
    B, S, _ = u.shape
    dt = u.dtype
    splits = [int(i) for i in np.cumsum(PROJ_SIZES)[:-1]]
    aq, ak, av, rq, rk, rv, rg, gq, gk, gv, gr, ga = jnp.split(u @ w_in, splits, axis=-1)
    aq = rms_norm(aq.reshape(B, S, ATT_HEADS, ATT_HEAD_DIM), q_norm)
    ak = rms_norm(ak.reshape(B, S, ATT_KV_HEADS, ATT_HEAD_DIM), k_norm)
    av = av.reshape(B, S, ATT_KV_HEADS, ATT_HEAD_DIM)
    rq = rq.reshape(B, S, RET_HEADS, RET_DK)
    rk = rk.reshape(B, S, RET_HEADS, RET_DK) * (RET_DK ** -0.5)
    rv = rv.reshape(B, S, RET_HEADS, RET_DV)
    if rope is not None:
        cos, sin = rope
        aq = apply_rope(aq, cos, sin)
        ak = apply_rope(ak, cos, sin)
        rq = apply_rope(rq, cos, sin)
        rk = apply_rope(rk, cos, sin)
    if ctx is None:
        keys, vals = ak, av
        s_ret0 = jnp.zeros((B, 2, RET_HEADS, RET_DK, RET_DV), F32)
        s_gla0 = jnp.zeros((B, 2, GLA_HEADS, GLA_DK, GLA_DV), F32)
    else:
        ck, cv, s_ret0, s_gla0 = ctx
        keys = jnp.concatenate([ck.astype(dt), ak], axis=1)
        vals = jnp.concatenate([cv.astype(dt), av], axis=1)
    att = blocked_attention(aq.reshape(B, S, ATT_KV_HEADS, ATT_GROUP, ATT_HEAD_DIM), keys, vals)

    rqf, rkf, rvf = rq.astype(F32), rk.astype(F32), rv.astype(F32)
    lg = log_decay.astype(F32)
    s_ret0 = s_ret0.astype(F32)
    ret_f, sr_f = retention_chunkwise(rqf, rkf, rvf, lg[0], s_ret0[:, 0])
    ret_b, sr_b = retention_chunkwise(rqf[:, ::-1], rkf[:, ::-1], rvf[:, ::-1], lg[1], s_ret0[:, 1])
    ret = head_group_norm(ret_f + ret_b[:, ::-1]).reshape(B, S, RET_WIDTH).astype(dt) * jax.nn.silu(rg)

    gqf = gq.reshape(B, S, GLA_HEADS, GLA_DK).astype(F32) * (GLA_DK ** -0.5)
    gkf = gk.reshape(B, S, GLA_HEADS, GLA_DK).astype(F32)
    gvf = gv.reshape(B, S, GLA_HEADS, GLA_DV).astype(F32)

    def gla_log_gate(d):
        pre = ga[..., d * GLA_GATE_RANK:(d + 1) * GLA_GATE_RANK] @ w_a2[d] + b_a[d]
        return (jax.nn.log_sigmoid(pre.astype(F32)) / GLA_TAU).reshape(B, S, GLA_HEADS, GLA_DK)

    s_gla0 = s_gla0.astype(F32)
    gla_f, sg_f = gla_chunkwise(gqf, gkf, gvf, gla_log_gate(0), s_gla0[:, 0])
    gla_b, sg_b = gla_chunkwise(gqf[:, ::-1], gkf[:, ::-1], gvf[:, ::-1], gla_log_gate(1)[:, ::-1], s_gla0[:, 1])
    gla = rms_norm(gla_f + gla_b[:, ::-1], gla_norm).reshape(B, S, GLA_WIDTH).astype(dt) * jax.nn.silu(gr)

    y = jnp.concatenate([att, ret, gla], axis=-1) @ w_out
    if ctx is None:
        new_ctx = (ak, av, jnp.stack([sr_f, sr_b], axis=1).astype(dt), jnp.stack([sg_f, sg_b], axis=1).astype(dt))
    else:
        new_ctx = None
    return y, new_ctx


def trunk_layer(x, mod, ln_g, ln_b, ffn_w_in, ffn_w_out, mixer_params, rope, ctx):
    m = [mod[:, i, None, :] for i in range(N_MOD)]

    def post(x, out, gate, weight, i):
        return layer_norm(DEEPNORM_ALPHA * x + weight * (gate * out), ln_g[i], ln_b[i])

    u = modulate(x, m[0], m[1])
    x = post(x, swiglu_ffn(u, ffn_w_in[0], ffn_w_out[0]), m[2], MACARON_WEIGHT, 0)
    u = modulate(x, m[3], m[4])
    y, new_ctx = token_mixer(u, *mixer_params, rope=rope, ctx=ctx)
    x = post(x, y, m[5], 1.0, 1)
    u = modulate(x, m[6], m[7])
    x = post(x, swiglu_ffn(u, ffn_w_in[1], ffn_w_out[1]), m[8], MACARON_WEIGHT, 2)
    return x, new_ctx


def setup_inputs(seed: int = 0) -> dict:
    key = jax.random.key(seed)
    ks = jax.random.split(key, 24)

    def nrm(k, shape, s=1.0):
        return s * jax.random.normal(k, shape, F32)

    ret_base = jnp.log1p(-(2.0 ** (-5.0 - jnp.arange(RET_HEADS, dtype=F32))))
    return {
        'x_prompt': nrm(ks[0], (BATCH, SEQ, D_MODEL)),
        'x_sample': nrm(ks[1], (DEC_BATCH, DEC_SEQ, D_MODEL)),
        'c': nrm(ks[2], (DEC_BATCH, D_MODEL)),
        'cache_attn_k': nrm(ks[3], (DEC_BATCH, DEPTH, PAST_LEN, ATT_KV_HEADS, ATT_HEAD_DIM)),
        'cache_attn_v': nrm(ks[4], (DEC_BATCH, DEPTH, PAST_LEN, ATT_KV_HEADS, ATT_HEAD_DIM)),
        'state_ret': nrm(ks[5], (DEC_BATCH, DEPTH, 2, RET_HEADS, RET_DK, RET_DV), 0.5),
        'state_gla': nrm(ks[6], (DEC_BATCH, DEPTH, 2, GLA_HEADS, GLA_DK, GLA_DV), 0.5),
        'c_ctx': nrm(ks[7], (D_MODEL,)),
        'w_mod': nrm(ks[8], (DEPTH, D_MODEL, N_MOD * D_MODEL), 0.5 * D_MODEL ** -0.5),
        'b_mod': nrm(ks[9], (DEPTH, N_MOD * D_MODEL), 0.01),
        'ln_g': 1.0 + nrm(ks[10], (DEPTH, 3, D_MODEL), 0.01),
        'ln_b': nrm(ks[11], (DEPTH, 3, D_MODEL), 0.01),
        'ffn_w_in': nrm(ks[12], (DEPTH, 2, D_MODEL, 2 * D_FF), D_MODEL ** -0.5),
        'ffn_w_out': nrm(ks[13], (DEPTH, 2, D_FF, D_MODEL), DEEPNORM_BETA * D_FF ** -0.5),
        'mix_w_in': nrm(ks[14], (DEPTH, D_MODEL, PROJ_COLS), D_MODEL ** -0.5),
        'mix_w_out': nrm(ks[15], (DEPTH, MIX_WIDTH, D_MODEL), DEEPNORM_BETA * MIX_WIDTH ** -0.5),
        'att_q_norm': 1.0 + nrm(ks[16], (DEPTH, ATT_HEAD_DIM), 0.01),
        'att_k_norm': 1.0 + nrm(ks[17], (DEPTH, ATT_HEAD_DIM), 0.01),
        'ret_log_decay': ret_base[None, None, :] * jnp.exp(nrm(ks[18], (DEPTH, 2, RET_HEADS), 0.1)),
        'gla_w_a2': nrm(ks[19], (DEPTH, 2, GLA_GATE_RANK, GLA_HEADS * GLA_DK), GLA_GATE_RANK ** -0.5),
        'gla_b_a': nrm(ks[20], (DEPTH, 2, GLA_HEADS * GLA_DK), 0.01),
        'gla_norm': 1.0 + nrm(ks[21], (DEPTH, GLA_DV), 0.01),
    }


def reference(x_prompt, x_sample, c, cache_attn_k, cache_attn_v, state_ret, state_gla, c_ctx,
              w_mod, b_mod, ln_g, ln_b, ffn_w_in, ffn_w_out, mix_w_in, mix_w_out,
              att_q_norm, att_k_norm, ret_log_decay, gla_w_a2, gla_b_a, gla_norm):
    h = x_prompt
    ks_l, vs_l, sr_l, sg_l = [], [], [], []
    for l in range(DEPTH):
        mod = (jax.nn.silu(c_ctx) @ w_mod[l] + b_mod[l]).reshape(1, N_MOD, D_MODEL)
        mixer_params = (mix_w_in[l], mix_w_out[l], att_q_norm[l], att_k_norm[l], ret_log_decay[l],
                        gla_w_a2[l], gla_b_a[l], gla_norm[l])
        h, (k_l, v_l, s_r, s_g) = trunk_layer(h, mod, ln_g[l], ln_b[l], ffn_w_in[l], ffn_w_out[l],
                                              mixer_params, None, None)
        ks_l.append(k_l)
        vs_l.append(v_l)
        sr_l.append(s_r)
        sg_l.append(s_g)
    y_prompt = h
    new_attn_k = jnp.stack(ks_l, axis=1)
    new_attn_v = jnp.stack(vs_l, axis=1)
    new_state_ret = jnp.stack(sr_l, axis=1)
    new_state_gla = jnp.stack(sg_l, axis=1)

    rows = x_sample.shape[1] // GRID_W
    rope = axial_rope_tables(rows)
    g = x_sample
    for l in range(DEPTH):
        mod = (jax.nn.silu(c) @ w_mod[l] + b_mod[l]).reshape(c.shape[0], N_MOD, D_MODEL)
        mixer_params = (mix_w_in[l], mix_w_out[l], att_q_norm[l], att_k_norm[l], ret_log_decay[l],
                        gla_w_a2[l], gla_b_a[l], gla_norm[l])
        ctx = (cache_attn_k[:, l], cache_attn_v[:, l], state_ret[:, l], state_gla[:, l])
        g, _ = trunk_layer(g, mod, ln_g[l], ln_b[l], ffn_w_in[l], ffn_w_out[l], mixer_params, rope, ctx)
    y_sample = g
    return (y_prompt, y_sample, new_attn_k, new_attn_v, new_state_ret, new_state_gla)
```

```cpp
#include <hip/hip_runtime.h>
#include <cstdio>
#include <cstdint>

#define LAS __attribute__((address_space(3)))
#define GAS __attribute__((address_space(1)))
typedef unsigned short bf16_t;
typedef short bf16x8 __attribute__((ext_vector_type(8)));
typedef short s16x4 __attribute__((ext_vector_type(4)));
typedef float f32x2 __attribute__((ext_vector_type(2)));
typedef float f32x4 __attribute__((ext_vector_type(4)));
typedef float f32x16 __attribute__((ext_vector_type(16)));
typedef unsigned u32x2 __attribute__((ext_vector_type(2)));
typedef unsigned u32x4 __attribute__((ext_vector_type(4)));

constexpr int DM = 2048, M_CTX = 4096, M_LAT = 8192, MT = 12288, DFF = 5632, NPROJP = 5376, DEPTH = 2;
constexpr int C_AQ = 0, C_AK = 1024, C_AV = 1280, C_RQ = 1536, C_RK = 2048, C_RV = 2560, C_RG = 3072, C_GQ = 3584, C_GK = 3840, C_GV = 4096, C_GR = 4608, C_GA = 5120;
constexpr size_t O_YP = 0, O_K = 25165824, O_V = 27262976, O_SR = 29360128, O_SG = 33554432, O_END = 35651584;
constexpr float LN_EPS = 1e-5f, RMS_EPS = 1e-6f, ALPHA = 1.41421356237309515f;
constexpr int LSEQ = 4352;
enum { I_XP = 0, I_XS, I_C, I_CK, I_CV, I_SR, I_SG, I_CCTX, I_WMOD, I_BMOD, I_LNG, I_LNB, I_WIN, I_WOUT, I_MWIN, I_MWOUT, I_QN, I_KN, I_RLD, I_WA2, I_BA, I_GN, N_IN };

constexpr size_t MiB = 1u << 20;
constexpr size_t WS_CTL = 0, CTL_ZERO_BYTES = 1 * MiB;
constexpr size_t WS_MOD = 1 * MiB, WS_ROPE = 2 * MiB, WS_GDEC = 3 * MiB, WS_MODP = 4 * MiB;
constexpr size_t WS_WIN = 11 * MiB, WS_WOUT = WS_WIN + 176 * MiB, WS_WMI = WS_WOUT + 88 * MiB, WS_WMO = WS_WMI + 42 * MiB;
constexpr size_t WS_U = WS_WMO + 16 * MiB, WS_H = WS_U + 48 * MiB, WS_Y = WS_H + 132 * MiB, WS_PROJ = WS_Y + 192 * MiB;
constexpr size_t WS_QB = WS_PROJ + 252 * MiB, WS_KB = WS_QB + 24 * MiB, WS_VB = WS_KB + 7 * MiB, WS_LA = WS_VB + 7 * MiB;
constexpr size_t WS_MA = WS_LA + 24 * MiB, WS_RKV = WS_MA + 48 * MiB, WS_GKV = WS_RKV + 48 * MiB, WS_RSP = WS_GKV + 48 * MiB, WS_GSP = WS_RSP + 24 * MiB, WS_GA = WS_GSP + 24 * MiB, WS_X = WS_GA + 2 * MiB, WS_U8 = WS_X + 48 * MiB, WS_END = WS_U8 + 24 * MiB;
constexpr unsigned MI_F8MASK = (1u << 0) | (1u << 1) | (1u << 2) | (1u << 3) | (1u << 6) | (1u << 7) | (1u << 12) | (1u << 13) | (1u << 14) | (1u << 18) | (1u << 19);
constexpr unsigned long long MI_F8TBL = 0ull | (1ull << 5) | (2ull << 10) | (3ull << 15) | (6ull << 20) | (7ull << 25) | (12ull << 30) | (13ull << 35) | (14ull << 40) | (18ull << 45) | (19ull << 50);
constexpr unsigned long long MI_B16TBL = 4ull | (5ull << 5) | (8ull << 10) | (9ull << 15) | (10ull << 20) | (11ull << 25) | (15ull << 30) | (16ull << 35) | (17ull << 40) | (20ull << 45);
constexpr size_t WMI8_OFF = 24 * MiB;
constexpr size_t KB_LAT_OFF = (size_t)16 * 256 * 256;
constexpr int CW_BAR = 4096;

constexpr int LDS_MAIN = 147456;
constexpr int LDS_RED = LDS_MAIN;
constexpr int LDS_MISC = LDS_MAIN + 4096;
constexpr int LDS_BYTES = 155648;

__device__ __forceinline__ int hw_lane() { int l; asm volatile("v_mbcnt_lo_u32_b32 %0, -1, 0\n\tv_mbcnt_hi_u32_b32 %0, -1, %0" : "=v"(l)); return l; }
__device__ __forceinline__ float shflx(float v, int m) { return __builtin_bit_cast(float, __builtin_amdgcn_ds_bpermute((hw_lane() ^ m) << 2, __builtin_bit_cast(int, v))); }
__device__ __forceinline__ unsigned f2bf(float f) { unsigned u = __builtin_bit_cast(unsigned, f); return (u + 0x7fffu + ((u >> 16) & 1u)) >> 16; }
__device__ __forceinline__ unsigned pk2(float lo, float hi) { unsigned r; asm("v_cvt_pk_bf16_f32 %0, %1, %2" : "=v"(r) : "v"(lo), "v"(hi)); return r; }
__device__ __forceinline__ unsigned cvt_pk_bf16(float lo, float hi) { unsigned r; asm volatile("v_cvt_pk_bf16_f32 %0, %1, %2" : "=v"(r) : "v"(lo), "v"(hi)); return r; }
__device__ __forceinline__ float siluf(float x) { return x * __builtin_amdgcn_rcpf(1.0f + __builtin_amdgcn_exp2f(-1.44269504089f * x)); }
template <int CTRL, int RM> __device__ __forceinline__ float dpp_acc(float v) { return v + __builtin_bit_cast(float, __builtin_amdgcn_update_dpp(0, __builtin_bit_cast(int, v), CTRL, RM, 0xf, false)); }
__device__ __forceinline__ float wave_prefix(float v) {
    v = dpp_acc<0x111, 0xf>(v); v = dpp_acc<0x112, 0xf>(v); v = dpp_acc<0x114, 0xf>(v); v = dpp_acc<0x118, 0xf>(v);
    v = dpp_acc<0x142, 0xa>(v); v = dpp_acc<0x143, 0xc>(v); return v;
}
__device__ __forceinline__ float wave_sum(float v) { return __builtin_bit_cast(float, __builtin_amdgcn_readlane(__builtin_bit_cast(int, wave_prefix(v)), 63)); }
__device__ __forceinline__ float half_sum32(float v) {
#pragma unroll
    for (int o = 1; o < 32; o <<= 1) v += shflx(v, o);
    return v;
}
__device__ __forceinline__ float grp_sum16(float v) {
#pragma unroll
    for (int o = 1; o < 16; o <<= 1) v += shflx(v, o);
    return v;
}
__device__ __forceinline__ f32x4 bf4_to_f32(u32x2 w) { return (f32x4){__uint_as_float(w.x << 16), __uint_as_float(w.x & 0xffff0000u), __uint_as_float(w.y << 16), __uint_as_float(w.y & 0xffff0000u)}; }
typedef int v4i_t __attribute__((ext_vector_type(4)));
typedef int v8i_t __attribute__((ext_vector_type(8)));
__device__ __forceinline__ unsigned pk4_fp8(float a, float b, float c, float d) {
    a = __builtin_amdgcn_fmed3f(a, -448.f, 448.f); b = __builtin_amdgcn_fmed3f(b, -448.f, 448.f); c = __builtin_amdgcn_fmed3f(c, -448.f, 448.f); d = __builtin_amdgcn_fmed3f(d, -448.f, 448.f);
    int w = 0; w = __builtin_amdgcn_cvt_pk_fp8_f32(a, b, w, false); w = __builtin_amdgcn_cvt_pk_fp8_f32(c, d, w, true); return (unsigned)w;
}
constexpr float S8_WIN = 64.f, S8_WOUT = 256.f, S8_H = 4.f, S8_WMO = 128.f, S8_MA = 4.f, S8_WMI = 64.f, S8_Y = 64.f;
__device__ __forceinline__ void bf8_to_f32(u32x4 w, float (&x)[8]) {
    x[0] = __uint_as_float(w.x << 16); x[1] = __uint_as_float(w.x & 0xffff0000u); x[2] = __uint_as_float(w.y << 16); x[3] = __uint_as_float(w.y & 0xffff0000u);
    x[4] = __uint_as_float(w.z << 16); x[5] = __uint_as_float(w.z & 0xffff0000u); x[6] = __uint_as_float(w.w << 16); x[7] = __uint_as_float(w.w & 0xffff0000u);
}
__device__ __forceinline__ u32x4 f32_to_bf8(const float (&x)[8]) { return (u32x4){pk2(x[0], x[1]), pk2(x[2], x[3]), pk2(x[4], x[5]), pk2(x[6], x[7])}; }
#define LDS_WAIT() asm volatile("s_waitcnt lgkmcnt(0)" ::: "memory")

__device__ __forceinline__ int launder_v(int x) { asm volatile("" : "+v"(x)); return x; }
__device__ __forceinline__ int launder_s(int x) { asm volatile("" : "+s"(x)); return x; }
namespace pg8 {
constexpr int BM = 256, BK = 64, HALF = 128, HTB = HALF * BK * 2, STAGE_BYTES = 8 * HTB, NXCD = 8, WGM = 8;
__host__ __device__ __forceinline__ int lds_byte(int r, int c) { const int st = (r >> 4) * 2 + (c >> 5), rr = r & 15, cc = c & 31, ob = rr * 64 + cc * 2; return st * 1024 + (ob ^ (((ob >> 9) & 1) << 5)); }
__host__ __device__ __forceinline__ void stage_rc(int b, int& R, int& C) { const int st = b / 1024, sb = b % 1024, swz = sb ^ (((sb >> 9) & 1) << 5); R = (st >> 1) * 16 + swz / 64; C = (st & 1) * 32 + (swz % 64) / 2; }
__host__ __device__ __forceinline__ int perm32(int rho) { const int n = rho >> 4, i = rho & 15; return 8 * (i >> 2) + 4 * n + (i & 3); }

struct Unit { int pm, pn, ks, k0, nt; };
struct Gemm { const bf16_t* A; const bf16_t* Bt; int lda, ldb, nt; };
struct Order {
    int nM, nN, nNx, nwg, G, c; bool m15;
    __device__ void init(int nM_, int nN_, int KS, int G_, int c_) { nM = nM_; nN = nN_; nNx = nN_ * KS; nwg = nM * nNx; G = G_; c = c_; m15 = (KS == 2 && G_ == 256 && nM_ == 48 && nN_ == 8); }
    __device__ bool next(int i, Unit& u, int nt) const {
        if (m15) {
            if (i > 1) return false;
            const int x = c & 7, j = c >> 3;
            if (i == 0) { u.pm = 6 * x + (j >> 3); u.pn = j & 7; u.ks = 0; u.k0 = 0; u.nt = 2 * nt; }
            else { const int ks = j & 1, q = j >> 1, P = (x >> 1) * 4 + (q >> 2); u.pm = 6 * (P >> 1) + 4 + (P & 1); u.pn = (x & 1) * 4 + (q & 3); u.ks = ks; u.k0 = ks * nt; u.nt = nt; }
            return true;
        }
        const long L = (long)i * G + c; if (L >= nwg) return false;
        int wgid = (int)L; { const int q = nwg / NXCD, r = nwg % NXCD, xcd = wgid % NXCD, off = wgid / NXCD; wgid = (xcd < r ? xcd * (q + 1) : r * (q + 1) + (xcd - r) * q) + off; }
        const int nig = WGM * nNx, gid = wgid / nig, fm = gid * WGM, gsz = (nM - fm) < WGM ? (nM - fm) : WGM;
        u.pm = fm + ((wgid % nig) % gsz); const int pnx = (wgid % nig) / gsz; u.ks = pnx / nN; u.pn = pnx - u.ks * nN; u.k0 = u.ks * nt; u.nt = nt; return true;
    }
};
struct EpiF32 {
    static constexpr bool PERM = false;
    float* C; int ldc; size_t ks_stride;
    __device__ __forceinline__ void operator()(const f32x4 (&acc)[2][2][4][2], const Unit& u, int wr, int wc, int fr, int fq) const {
        const int row0 = u.pm * BM + wr * 64 + fr, col0 = u.pn * BM + wc * 32 + 4 * fq;
        float* Cb = C + (size_t)u.ks * ks_stride;
#pragma unroll
        for (int ai = 0; ai < 2; ++ai)
#pragma unroll
            for (int m = 0; m < 4; ++m) { float* rowp = Cb + (size_t)(row0 + ai * HALF + m * 16) * ldc + col0;
#pragma unroll
                for (int bj = 0; bj < 2; ++bj)
#pragma unroll
                    for (int n = 0; n < 2; ++n) *(f32x4*)(rowp + bj * HALF + n * 16) = acc[ai][bj][m][n]; }
    }
};
struct EpiBf16 {
    static constexpr bool PERM = true;
    bf16_t* O; int ldc; size_t ks_stride; float scale;
    __device__ __forceinline__ void operator()(const f32x4 (&acc)[2][2][4][2], const Unit& u, int wr, int wc, int fr, int fq) const {
        const int row0 = u.pm * BM + wr * 64 + fr, col0 = u.pn * BM + wc * 32 + 8 * fq;
        bf16_t* Ob = O + (size_t)u.ks * ks_stride;
#pragma unroll
        for (int ai = 0; ai < 2; ++ai)
#pragma unroll
            for (int m = 0; m < 4; ++m) { bf16_t* rowp = Ob + (size_t)(row0 + ai * HALF + m * 16) * ldc + col0;
#pragma unroll
                for (int bj = 0; bj < 2; ++bj) { const f32x4 v0 = acc[ai][bj][m][0] * scale, v1 = acc[ai][bj][m][1] * scale;
                    u32x4 w; w.x = cvt_pk_bf16(v0[0], v0[1]); w.y = cvt_pk_bf16(v0[2], v0[3]); w.z = cvt_pk_bf16(v1[0], v1[1]); w.w = cvt_pk_bf16(v1[2], v1[3]);
                    *(u32x4*)(rowp + bj * HALF) = w; } }
    }
};
struct EpiFp8 {
    static constexpr bool PERM = true;
    unsigned char* O; int ldc; size_t ks_stride; float scale;
    __device__ __forceinline__ void operator()(const f32x4 (&acc)[2][2][4][2], const Unit& u, int wr, int wc, int fr, int fq) const {
        const int row0 = u.pm * BM + wr * 64 + fr, col0 = u.pn * BM + wc * 32 + 8 * fq;
        unsigned char* Ob = O + (size_t)u.ks * ks_stride;
#pragma unroll
        for (int ai = 0; ai < 2; ++ai)
#pragma unroll
            for (int m = 0; m < 4; ++m) { unsigned char* rowp = Ob + (size_t)(row0 + ai * HALF + m * 16) * ldc + col0;
#pragma unroll
                for (int bj = 0; bj < 2; ++bj) { const f32x4 v0 = acc[ai][bj][m][0] * scale, v1 = acc[ai][bj][m][1] * scale;
                    *(u32x2*)(rowp + bj * HALF) = (u32x2){pk4_fp8(v0[0], v0[1], v0[2], v0[3]), pk4_fp8(v1[0], v1[1], v1[2], v1[3])}; } }
    }
};
struct EpiProj {
    static constexpr bool PERM = true;
    bf16_t* O; int ldc; float* GA; unsigned long long tbl; float scale;
    __device__ __forceinline__ void operator()(const f32x4 (&acc)[2][2][4][2], const Unit& u, int wr, int wc, int fr, int fq) const {
        const int gpn = (int)((tbl >> (5 * u.pn)) & 31ull);
        const int row0 = u.pm * BM + wr * 64 + fr, col0 = gpn * BM + wc * 32 + 8 * fq;
        if (gpn == 20) {
            if (wc == 0) {
#pragma unroll
                for (int ai = 0; ai < 2; ++ai)
#pragma unroll
                    for (int m = 0; m < 4; ++m) { float* g = GA + (size_t)(row0 + ai * HALF + m * 16) * 32 + 8 * fq;
                        *(f32x4*)g = acc[ai][0][m][0] * scale; *(f32x4*)(g + 4) = acc[ai][0][m][1] * scale; }
            }
            return;
        }
#pragma unroll
        for (int ai = 0; ai < 2; ++ai)
#pragma unroll
            for (int m = 0; m < 4; ++m) { bf16_t* rowp = O + (size_t)(row0 + ai * HALF + m * 16) * ldc + col0;
#pragma unroll
                for (int bj = 0; bj < 2; ++bj) { const f32x4 v0 = acc[ai][bj][m][0] * scale, v1 = acc[ai][bj][m][1] * scale;
                    u32x4 w; w.x = cvt_pk_bf16(v0[0], v0[1]); w.y = cvt_pk_bf16(v0[2], v0[3]); w.z = cvt_pk_bf16(v1[0], v1[1]); w.w = cvt_pk_bf16(v1[2], v1[3]);
                    *(u32x4*)(rowp + bj * HALF) = w; } }
    }
};
struct EpiSwiGLU8 {
    static constexpr bool PERM = true;
    unsigned char* H; int ldc;
    __device__ __forceinline__ void operator()(const f32x4 (&acc)[2][2][4][2], const Unit& u, int wr, int wc, int fr, int fq) const {
        const int row0 = u.pm * BM + wr * 64 + fr, col0 = u.pn * HALF + wc * 32 + 8 * fq;
        constexpr float DS = 1.0f / S8_WIN;
        f32x2 kc; asm volatile("v_mov_b32 %0, %1" : "=v"(kc[0]) : "s"(-DS * 1.44269504089f)); asm volatile("v_mov_b32 %0, %1" : "=v"(kc[1]) : "s"(1.0f / (DS * DS * S8_H)));
        const f32x4 c1v = {kc[0], kc[0], kc[0], kc[0]}, ic2v = {kc[1], kc[1], kc[1], kc[1]};
#pragma unroll
        for (int ai = 0; ai < 2; ++ai)
#pragma unroll
            for (int m = 0; m < 4; ++m) { unsigned char* rowp = H + (size_t)(row0 + ai * HALF + m * 16) * ldc + col0;
                u32x2 w;
#pragma unroll
                for (int n = 0; n < 2; ++n) { const f32x4 ag = acc[ai][0][m][n], au = acc[ai][1][m][n]; const f32x4 t = ag * c1v; f32x4 e, r;
#pragma unroll
                    for (int i = 0; i < 4; ++i) e[i] = __builtin_amdgcn_exp2f(t[i]);
                    const f32x4 d = e * ic2v + ic2v;
#pragma unroll
                    for (int i = 0; i < 4; ++i) r[i] = __builtin_amdgcn_rcpf(d[i]);
                    const f32x4 hv = (ag * au) * r;
                    const unsigned pk = pk4_fp8(hv[0], hv[1], hv[2], hv[3]); if (n == 0) w.x = pk; else w.y = pk; }
                *(u32x2*)rowp = w; }
    }
};

template <bool FP8, class Epi>
__device__ __forceinline__ void gemm_phase(LAS unsigned char* lds, const Gemm g, const Order& S, const Epi& E, const int tid) {
    const int wid = __builtin_amdgcn_readfirstlane(tid >> 6), lane = tid & 63, wr = wid >> 2, wc = wid & 3, fr = lane & 15, fq = lane >> 4;
    const int nt = g.nt;
    auto stage_off = [&](bool isB) -> unsigned { const int t_ = tid; int R, C; stage_rc(t_ * 16, R, C); const int Rb = (isB && Epi::PERM) ? ((R & ~31) + perm32(R & 31)) : R;
        return (unsigned)(Rb * (isB ? g.ldb : g.lda) + C) * 2u; };
    const unsigned voffA0 = stage_off(false), voffB0 = stage_off(true);
    const size_t pstepA = (size_t)64 * g.lda * 2, pstepB = (size_t)64 * g.ldb * 2;
    const size_t kstep = (size_t)(BK * 2);
    const size_t hstepA = (size_t)HALF * g.lda * 2, hstepB = (size_t)HALF * g.ldb * 2;
    const size_t tstepA = 2 * hstepA, tstepB = 2 * hstepB;
    const unsigned ldsw = (unsigned)wid * 1024u; const unsigned ldsb = (unsigned)(size_t)lds + ldsw;
    const int aoff = lds_byte(wr * 64 + fr, fq * 8), boff = lds_byte(wc * 32 + fr, fq * 8);
#define PG8_SA(b, h) (((b) * 2 + (h)) * HTB)
#define PG8_SB(b, h) ((4 + (b) * 2 + (h)) * HTB)
#define voffA false
#define voffB true
#define PG8_STAGE(bufoff, gbase, isB) do { const unsigned vo_ = (isB) ? voffB0 : voffA0; _Pragma("unroll") for (int _i = 0; _i < 2; ++_i) { \
        const char* gb_ = (const char*)(gbase) + _i * ((isB) ? pstepB : pstepA); const unsigned la_ = ldsb + (unsigned)(bufoff) + (unsigned)(_i * 8192); \
          \
        asm volatile("s_mov_b32 m0, %0\n\ts_nop 0\n\tglobal_load_lds_dwordx4 %1, %2" :: "s"(la_), "v"(vo_), "s"(gb_) : "memory", "m0"); } } while (0)
#define PG8_LDA(dst, b, h) do { _Pragma("unroll") for (int m = 0; m < 4; ++m) _Pragma("unroll") for (int k = 0; k < 2; ++k) dst[m][k] = *(const LAS bf16x8*)(lds + PG8_SA(b, h) + aoff + m * 2048 + k * 1024); } while (0)
#define PG8_LDB(dst, b, h) do { _Pragma("unroll") for (int n = 0; n < 2; ++n) _Pragma("unroll") for (int k = 0; k < 2; ++k) dst[n][k] = *(const LAS bf16x8*)(lds + PG8_SB(b, h) + boff + n * 2048 + k * 1024); } while (0)
#define PG8_CAT8(x) __builtin_shufflevector(__builtin_bit_cast(v4i_t, (x)[0]), __builtin_bit_cast(v4i_t, (x)[1]), 0, 1, 2, 3, 4, 5, 6, 7)
#define PG8_MMA(ai, bj, At, Bt) do { __builtin_amdgcn_s_setprio(1); _Pragma("unroll") for (int m = 0; m < 4; ++m) _Pragma("unroll") for (int n = 0; n < 2; ++n) { \
        if constexpr (FP8) acc[ai][bj][m][n] = __builtin_amdgcn_mfma_scale_f32_16x16x128_f8f6f4(PG8_CAT8(Bt[n]), PG8_CAT8(At[m]), acc[ai][bj][m][n], 0, 0, 0, 0, 0, 0); \
        else { _Pragma("unroll") for (int k = 0; k < 2; ++k) acc[ai][bj][m][n] = __builtin_amdgcn_mfma_f32_16x16x32_bf16(Bt[n][k], At[m][k], acc[ai][bj][m][n], 0, 0, 0); } } \
        __builtin_amdgcn_s_setprio(0); } while (0)
#define PG8_WAIT_V(n) asm volatile("s_waitcnt vmcnt(" #n ")" ::: "memory")
#define PG8_WAIT_L(n) asm volatile("s_waitcnt lgkmcnt(" #n ")" ::: "memory")
#define PG8_BAR __builtin_amdgcn_s_barrier()
#define PG8_SCHED __builtin_amdgcn_sched_barrier(0)
    Unit cur, nxt; int ui = 0;
    if (!S.next(0, cur, nt)) return;
    f32x4 acc[2][2][4][2];
#pragma unroll
    for (int a = 0; a < 2; ++a)
#pragma unroll
        for (int b = 0; b < 2; ++b)
#pragma unroll
            for (int m = 0; m < 4; ++m)
#pragma unroll
                for (int n = 0; n < 2; ++n) acc[a][b][m][n] = (f32x4){0.f, 0.f, 0.f, 0.f};
    bf16x8 At[4][2], B0[2][2], B1[2][2];
    const char* cA = (const char*)g.A + (size_t)cur.pm * tstepA + (size_t)cur.k0 * kstep;
    const char* cB = (const char*)g.Bt + (size_t)cur.pn * tstepB + (size_t)cur.k0 * kstep;
    PG8_STAGE(PG8_SB(0, 0), cB, voffB); PG8_STAGE(PG8_SB(0, 1), cB + hstepB, voffB); PG8_STAGE(PG8_SA(0, 0), cA, voffA); PG8_STAGE(PG8_SA(0, 1), cA + hstepA, voffA);
    if (wr == 1) PG8_BAR;
    PG8_WAIT_V(2); PG8_BAR;
    PG8_STAGE(PG8_SB(1, 0), cB + kstep, voffB); PG8_STAGE(PG8_SA(1, 0), cA + kstep, voffA); PG8_STAGE(PG8_SB(1, 1), cB + hstepB + kstep, voffB);
    PG8_WAIT_V(6); PG8_BAR;
    for (;;) {
        const bool has_next = S.next(ui + 1, nxt, nt);
        const char* nA = has_next ? (const char*)g.A + (size_t)nxt.pm * tstepA + (size_t)nxt.k0 * kstep : cA;
        const char* nB = has_next ? (const char*)g.Bt + (size_t)nxt.pn * tstepB + (size_t)nxt.k0 * kstep : cB;
        const int cnt = cur.nt;
        for (int t = 0; t < cnt; t += 2) {
            const bool last = (t == cnt - 2);
            const char* a1 = cA + (size_t)(t + 1) * kstep;
            const char* a2 = last ? nA : cA + (size_t)(t + 2) * kstep; const char* b2 = last ? nB : cB + (size_t)(t + 2) * kstep;
            const char* a3 = a2 + kstep; const char* b3 = b2 + kstep;
            PG8_LDB(B0, 0, 0); PG8_LDB(B1, 0, 1); PG8_SCHED; PG8_LDA(At, 0, 0); PG8_STAGE(PG8_SA(1, 1), a1 + hstepA, voffA);
            PG8_WAIT_V(8); PG8_WAIT_L(0); PG8_BAR; PG8_MMA(0, 0, At, B0); PG8_MMA(0, 1, At, B1); PG8_BAR; PG8_SCHED;
            PG8_LDA(At, 0, 1); PG8_STAGE(PG8_SB(0, 0), b2, voffB); PG8_STAGE(PG8_SB(0, 1), b2 + hstepB, voffB); PG8_STAGE(PG8_SA(0, 0), a2, voffA);
            PG8_WAIT_V(8); PG8_WAIT_L(0); PG8_BAR; PG8_MMA(1, 0, At, B0); PG8_MMA(1, 1, At, B1); PG8_BAR; PG8_SCHED;
            PG8_LDB(B0, 1, 0); PG8_LDB(B1, 1, 1); PG8_SCHED; PG8_LDA(At, 1, 0); PG8_STAGE(PG8_SA(0, 1), a2 + hstepA, voffA);
            PG8_WAIT_V(8); PG8_WAIT_L(0); PG8_BAR; PG8_MMA(0, 0, At, B0); PG8_MMA(0, 1, At, B1); PG8_BAR; PG8_SCHED;
            PG8_LDA(At, 1, 1); PG8_STAGE(PG8_SB(1, 0), b3, voffB); PG8_STAGE(PG8_SB(1, 1), b3 + hstepB, voffB); PG8_STAGE(PG8_SA(1, 0), a3, voffA);
            PG8_WAIT_V(8); PG8_WAIT_L(0); PG8_BAR; PG8_MMA(1, 0, At, B0); PG8_MMA(1, 1, At, B1); PG8_BAR; PG8_SCHED;
        }
        if (wr == 0) PG8_BAR;
        { const int l2 = launder_v(tid) & 63; E(acc, cur, wr, wc, l2 & 15, l2 >> 4); }
        if (!has_next) break;
#pragma unroll
        for (int a = 0; a < 2; ++a)
#pragma unroll
            for (int b = 0; b < 2; ++b)
#pragma unroll
                for (int m = 0; m < 4; ++m)
#pragma unroll
                    for (int n = 0; n < 2; ++n) { f32x2 lo_, hi_; asm volatile("v_pk_mov_b32 %0, 0, 0" : "=v"(lo_)); asm volatile("v_pk_mov_b32 %0, 0, 0" : "=v"(hi_));
                        acc[a][b][m][n] = (f32x4){lo_[0], lo_[1], hi_[0], hi_[1]}; }
        cur = nxt; cA = nA; cB = nB; ++ui;
        if (wr == 1) PG8_BAR;
    }
    PG8_WAIT_V(0);
    PG8_BAR;
#undef PG8_SA
#undef PG8_SB
#undef PG8_STAGE
#undef voffA
#undef voffB
#undef PG8_LDA
#undef PG8_LDB
#undef PG8_MMA
#undef PG8_CAT8
#undef PG8_WAIT_V
#undef PG8_WAIT_L
#undef PG8_BAR
#undef PG8_SCHED
}
}

namespace att {
constexpr int D = 128, NW = 8, QBLK = 32, KVBLK = 64;
constexpr float SCALE = 0.088388347648318440f;
constexpr float THR = 8.f;
constexpr int LDQ = 1024, LDK = 256, LDO = 2048;
constexpr size_t SHM_V = KVBLK * D * 2, SHM_K = KVBLK * D * 2, SHM_ATTN = 2 * SHM_V + 2 * SHM_K + NW * 64 * 4;
#define KSWZ(row, colB) ((row) * 256 + ((colB) ^ (((row) & 7) << 4)))
#define SBAR() __builtin_amdgcn_sched_barrier(0)
__device__ __forceinline__ int crow(int r, int hi) { return (r & 3) + 8 * (r >> 2) + 4 * hi; }
__device__ __forceinline__ unsigned cvtpk(float lo, float hi) { unsigned r; asm volatile("v_cvt_pk_bf16_f32 %0, %1, %2" : "=v"(r) : "v"(lo), "v"(hi)); return r; }
__device__ __forceinline__ void partialSM(f32x16& p0, f32x16& p1, float& m_reg, float& mn, float& alpha) {
  constexpr float C = SCALE * 1.4426950408889634f;
  float pmax = p0[0]; for (int r = 1; r < 16; ++r) pmax = fmaxf(pmax, p0[r]); for (int r = 0; r < 16; ++r) pmax = fmaxf(pmax, p1[r]);
  { auto rr = __builtin_amdgcn_permlane32_swap(__float_as_uint(pmax), __float_as_uint(pmax), false, false);
    pmax = fmaxf(__uint_as_float(rr[0]), __uint_as_float(rr[1])); }
  if (__builtin_expect(__all(pmax - m_reg <= THR / SCALE), 1)) { mn = m_reg; alpha = 1.f; }
  else { mn = fmaxf(m_reg, pmax); alpha = __builtin_amdgcn_exp2f((m_reg - mn) * C); m_reg = mn; }
  float mnC = -mn * C;
  for (int r = 0; r < 16; ++r) p0[r] = fmaf(p0[r], C, mnC); for (int r = 0; r < 16; ++r) p1[r] = fmaf(p1[r], C, mnC);
  for (int r = 0; r < 16; ++r) p0[r] = __builtin_amdgcn_exp2f(p0[r]);
}
__device__ __forceinline__ void finishSM(f32x16& p0, f32x16& p1, float alpha, float& l_reg, bf16x8& pa0, bf16x8& pa1, bf16x8& pa2, bf16x8& pa3) {
  for (int r = 0; r < 16; ++r) p1[r] = __builtin_amdgcn_exp2f(p1[r]);
  float ps = 0; for (int r = 0; r < 16; ++r) ps += p0[r]; for (int r = 0; r < 16; ++r) ps += p1[r];
  { auto rr = __builtin_amdgcn_permlane32_swap(__float_as_uint(ps), __float_as_uint(ps), false, false);
    ps = __uint_as_float(rr[0]) + __uint_as_float(rr[1]); }
  l_reg = l_reg * alpha + ps;
#define PK4(P, BASE, OUT) do { unsigned a0 = cvtpk(P[BASE + 0], P[BASE + 1]), a1 = cvtpk(P[BASE + 2], P[BASE + 3]);   \
    unsigned b0 = cvtpk(P[BASE + 4], P[BASE + 5]), b1 = cvtpk(P[BASE + 6], P[BASE + 7]);                              \
    auto r0 = __builtin_amdgcn_permlane32_swap(a0, b0, false, false); auto r1 = __builtin_amdgcn_permlane32_swap(a1, b1, false, false); \
    u32x4 w = {r0[0], r1[0], r0[1], r1[1]}; OUT = *reinterpret_cast<bf16x8*>(&w); } while (0)
  PK4(p0, 0, pa0); PK4(p0, 8, pa1); PK4(p1, 0, pa2); PK4(p1, 8, pa3);
#undef PK4
}
__device__ __forceinline__ void qkt(f32x16& p0, f32x16& p1, const bf16_t* Ks, const bf16x8* qr, int r32, int hi) {
  p0 = f32x16{}; p1 = f32x16{};
  for (int d0 = 0; d0 < 8; ++d0) { int cb = (d0 * 16 + hi * 8) * 2;
    bf16x8 b0 = *reinterpret_cast<const bf16x8*>((const char*)Ks + KSWZ(r32, cb));
    bf16x8 b1 = *reinterpret_cast<const bf16x8*>((const char*)Ks + KSWZ(32 + r32, cb));
    p0 = __builtin_amdgcn_mfma_f32_32x32x16_bf16(b0, qr[d0], p0, 0, 0, 0);
    p1 = __builtin_amdgcn_mfma_f32_32x32x16_bf16(b1, qr[d0], p1, 0, 0, 0); }
}
__device__ __forceinline__ int v_st(int k, int c) { const int kk = (k & ~0xC) | ((k & 4) << 1) | ((k & 8) >> 1); return ((kk >> 3) * 4 + (c >> 5)) * 512 + ((kk & 7) * 32 + (c & 31)) * 2; }
__device__ __forceinline__ int v_rd_base(int lane) { return ((lane & 3) << 3) | (((lane >> 2) & 3) << 6) | (((lane >> 4) & 1) << 5) | (((lane >> 5) & 1) << 8); }
constexpr int v_rd_off(int d0, int ks, int half) { return d0 * 512 + ks * 4096 + half * 2048; }
template <int OFF> __device__ __forceinline__ s16x4 tr_read(int vb) {
  s16x4 r; asm volatile("ds_read_b64_tr_b16 %0, %1 offset:%2" : "=&v"(r) : "v"(vb), "i"(OFF) : "memory"); return r;
}
template <int D0> __device__ __forceinline__ void pv_one(f32x16& od, int vb, bf16x8 pa0, bf16x8 pa1, bf16x8 pa2, bf16x8 pa3) {
  const s16x4 l0 = tr_read<v_rd_off(D0, 0, 0)>(vb), h0 = tr_read<v_rd_off(D0, 0, 1)>(vb), l1 = tr_read<v_rd_off(D0, 1, 0)>(vb), h1 = tr_read<v_rd_off(D0, 1, 1)>(vb);
  const s16x4 l2 = tr_read<v_rd_off(D0, 2, 0)>(vb), h2 = tr_read<v_rd_off(D0, 2, 1)>(vb), l3 = tr_read<v_rd_off(D0, 3, 0)>(vb), h3 = tr_read<v_rd_off(D0, 3, 1)>(vb);
  asm volatile("s_waitcnt lgkmcnt(0)" ::: "memory"); SBAR();
#define PK(L, H) (bf16x8){L[0], L[1], L[2], L[3], H[0], H[1], H[2], H[3]}
  od = __builtin_amdgcn_mfma_f32_32x32x16_bf16(pa0, PK(l0, h0), od, 0, 0, 0);
  od = __builtin_amdgcn_mfma_f32_32x32x16_bf16(pa1, PK(l1, h1), od, 0, 0, 0);
  od = __builtin_amdgcn_mfma_f32_32x32x16_bf16(pa2, PK(l2, h2), od, 0, 0, 0);
  od = __builtin_amdgcn_mfma_f32_32x32x16_bf16(pa3, PK(l3, h3), od, 0, 0, 0);
#undef PK
}
__device__ __forceinline__ void pv_d0(f32x16* o, int vb, bf16x8 pa0, bf16x8 pa1, bf16x8 pa2, bf16x8 pa3) {
  pv_one<0>(o[0], vb, pa0, pa1, pa2, pa3); pv_one<1>(o[1], vb, pa0, pa1, pa2, pa3); pv_one<2>(o[2], vb, pa0, pa1, pa2, pa3); pv_one<3>(o[3], vb, pa0, pa1, pa2, pa3);
}
__device__ __forceinline__ void attn_unit(const bf16_t* __restrict__ Qb, const bf16_t* __restrict__ Kh, const bf16_t* __restrict__ Vh, unsigned char* __restrict__ Ob, int seq, char* lds, const int tid) {
  const int wid = tid >> 6, lane = tid & 63, r32 = lane & 31, hi = lane >> 5;
  bf16_t* V_lds = (bf16_t*)lds; bf16_t* K_lds = (bf16_t*)(lds + 2 * SHM_V);
  float* ws = (float*)(lds + 2 * SHM_V + 2 * SHM_K) + wid * 64; float* li_l = ws; float* al_l = ws + 32;
  float m_reg = -1e30f, l_reg = 0; f32x16 o[4] = {}; bf16x8 qr[8];
  const bf16_t* Qw = Qb + (long)(wid * QBLK + r32) * LDQ + hi * 8;
#pragma unroll
  for (int d0 = 0; d0 < 8; ++d0) qr[d0] = *reinterpret_cast<const bf16x8*>(Qw + d0 * 16);
  const int sr = tid >> 4, sc = (tid & 15) * 8, vst0 = v_st(sr, sc), vst1 = v_st(32 + sr, sc);
  const int vb0 = (int)(uintptr_t)V_lds + v_rd_base(lane);
  struct { bf16x8 vs0, vs1, ks0, ks1; } sr_[2];
#define SLOAD(i, k0) do { sr_[i].vs0 = *reinterpret_cast<const bf16x8*>(&Vh[(long)((k0) + sr) * LDK + sc]); sr_[i].vs1 = *reinterpret_cast<const bf16x8*>(&Vh[(long)((k0) + 32 + sr) * LDK + sc]); \
    sr_[i].ks0 = *reinterpret_cast<const bf16x8*>(&Kh[(long)((k0) + sr) * LDK + sc]); sr_[i].ks1 = *reinterpret_cast<const bf16x8*>(&Kh[(long)((k0) + 32 + sr) * LDK + sc]); } while (0)
#define SWRITE(b, i) do { *(bf16x8*)((char*)V_lds + (b) * SHM_V + vst0) = sr_[i].vs0;          \
    *(bf16x8*)((char*)V_lds + (b) * SHM_V + vst1) = sr_[i].vs1; int kc = sc * 2;               \
    *(bf16x8*)((char*)K_lds + (b) * SHM_K + KSWZ(sr, kc)) = sr_[i].ks0;                       \
    *(bf16x8*)((char*)K_lds + (b) * SHM_K + KSWZ(32 + sr, kc)) = sr_[i].ks1; } while (0)
#define SWAIT() asm volatile("s_waitcnt vmcnt(4)" ::: "memory")
#define RESC(a) do { if (__any((a) < 1.f)) { if (hi == 0) al_l[r32] = (a); asm volatile("s_waitcnt lgkmcnt(0)" ::: "memory"); \
    for (int d = 0; d < 4; ++d) for (int r = 0; r < 16; ++r) o[d][r] *= al_l[crow(r, hi)]; } } while (0)
  f32x16 pA0, pA1, pB0, pB1; float mnA, mnB, alA, alB; bf16x8 pa0, pa1, pa2, pa3; const int NT = seq / KVBLK;
  constexpr int SE = 0, SO = 1;
  SLOAD(SE, 0); asm volatile("s_waitcnt vmcnt(0)" ::: "memory"); SWRITE(0, SE); __syncthreads();
  qkt(pA0, pA1, K_lds, qr, r32, hi); partialSM(pA0, pA1, m_reg, mnA, alA);
  SLOAD(SO, KVBLK); if (2 < NT) SLOAD(SE, 2 * KVBLK);
  SWAIT(); SWRITE(1, SO); __syncthreads();
  for (int j = 1; j + 1 < NT; j += 2) {
    SBAR(); qkt(pB0, pB1, (bf16_t*)((char*)K_lds + SHM_K), qr, r32, hi);
    finishSM(pA0, pA1, alA, l_reg, pa0, pa1, pa2, pa3); SBAR();
    SLOAD(SO, (j + 2) * KVBLK); SBAR();
    pv_d0(o, vb0, pa0, pa1, pa2, pa3); partialSM(pB0, pB1, m_reg, mnB, alB);
    __syncthreads(); SWAIT(); SWRITE(0, SE);
    RESC(alB); __syncthreads();
    SBAR(); qkt(pA0, pA1, K_lds, qr, r32, hi);
    finishSM(pB0, pB1, alB, l_reg, pa0, pa1, pa2, pa3); SBAR();
    if (j + 3 < NT) SLOAD(SE, (j + 3) * KVBLK); SBAR();
    pv_d0(o, vb0 + (int)SHM_V, pa0, pa1, pa2, pa3); partialSM(pA0, pA1, m_reg, mnA, alA);
    __syncthreads(); SWAIT(); SWRITE(1, SO);
    RESC(alA); __syncthreads();
  }
  SBAR(); qkt(pB0, pB1, (bf16_t*)((char*)K_lds + SHM_K), qr, r32, hi);
  finishSM(pA0, pA1, alA, l_reg, pa0, pa1, pa2, pa3); SBAR();
  pv_d0(o, vb0, pa0, pa1, pa2, pa3); partialSM(pB0, pB1, m_reg, mnB, alB);
  __syncthreads(); RESC(alB);
  finishSM(pB0, pB1, alB, l_reg, pa0, pa1, pa2, pa3); SBAR();
  pv_d0(o, vb0 + (int)SHM_V, pa0, pa1, pa2, pa3);
  if (hi == 0) li_l[r32] = l_reg; asm volatile("s_waitcnt lgkmcnt(0)" ::: "memory");
  float rli[16];
#pragma unroll
  for (int r = 0; r < 16; ++r) rli[r] = __builtin_amdgcn_rcpf(li_l[crow(r, hi)]);
  { int le = lane; asm volatile("" : "+v"(le));
    const int r32e = le & 31, hie = le >> 5;
    unsigned char* ot = (unsigned char*)lds + 69632 + wid * 4096;
#pragma unroll
    for (int r = 0; r < 16; ++r) { const int orow = crow(r, hie);
      const float rl4 = rli[r] * S8_MA; const unsigned w = pk4_fp8(o[0][r] * rl4, o[1][r] * rl4, o[2][r] * rl4, o[3][r] * rl4);
      for (int d0 = 0; d0 < 4; ++d0) ot[orow * 128 + d0 * 32 + r32e] = (unsigned char)(w >> (8 * d0)); }
    asm volatile("s_waitcnt lgkmcnt(0)" ::: "memory");
    unsigned char* Ow = Ob + (long)(wid * QBLK + (le >> 3)) * LDO + (le & 7) * 16;
#pragma unroll
    for (int k = 0; k < 4; ++k) *(u32x4*)(Ow + (long)(8 * k) * LDO) = *(const u32x4*)(ot + k * 1024 + le * 16); }
#undef SLOAD
#undef SWRITE
#undef SWAIT
#undef RESC
}
}

#define XB_TMO      128
#define XB_XCNT(j)  (256  + 64 * (j))
#define XB_XSUB(j)  (1280 + 64 * (j))
#define XB_XGEN(j)  (2304 + 64 * (j))
#define XB_TOP      3328
#define XB_TOPGEN   3392
#define XCD_BAR_WORDS 3456
#define XB_SPIN_CAP (1u << 22)
__device__ __forceinline__ unsigned xb_ld(unsigned* p)              { return __hip_atomic_load(p, __ATOMIC_RELAXED, __HIP_MEMORY_SCOPE_AGENT); }
__device__ __forceinline__ unsigned xb_add(unsigned* p, unsigned v) { return __hip_atomic_fetch_add(p, v, __ATOMIC_RELAXED, __HIP_MEMORY_SCOPE_AGENT); }
__device__ __forceinline__ unsigned xb_xcc_id() { return (unsigned)__builtin_amdgcn_s_getreg((3 << 11) | 20) & 0xFu; }
#define XB_SPIN(cond, bar) do { unsigned _sp = 0; while (cond) { __builtin_amdgcn_s_sleep(1); \
    if ((++_sp & 255u) == 0u) { if (xb_ld(&(bar)[XB_TMO])) break; if (_sp > XB_SPIN_CAP) { atomicAdd(&(bar)[XB_TMO], 1u); break; } } } } while (0)
struct XcdBarrier { unsigned* bar; unsigned x; volatile LAS unsigned* st; bool lead; };
__device__ __forceinline__ XcdBarrier xcd_barrier_post(unsigned* bar, volatile LAS unsigned* st, bool lead) {
    XcdBarrier b; b.bar = bar; b.x = xb_xcc_id(); b.st = st; b.lead = lead;
    if (lead && hw_lane() == 0) (void)xb_add(&bar[XB_XCNT(b.x)], 1u);
    return b;
}
__device__ __forceinline__ void xcd_barrier_complete(unsigned* bar, unsigned x, unsigned& nloc, unsigned& nx) {
    const unsigned G = gridDim.x * gridDim.y * gridDim.z;
    unsigned sum, cnt, mine, sp = 0u;
    for (;;) {
        sum = 0u; cnt = 0u; mine = 0u;
#pragma unroll
        for (unsigned j = 0; j < 16; ++j) { const unsigned c = xb_ld(&bar[XB_XCNT(j)]); sum += c; cnt += (c > 0u) ? 1u : 0u; mine = (j == x) ? c : mine; }
        if (sum == G) break;
        __builtin_amdgcn_s_sleep(1);
        if ((++sp & 255u) == 0u) { if (xb_ld(&bar[XB_TMO])) break; if (sp > XB_SPIN_CAP) { atomicAdd(&bar[XB_TMO], 1u); break; } }
    }
    nloc = mine > 0u ? mine : 1u; nx = cnt > 0u ? cnt : 1u;
}
__device__ __forceinline__ void xcd_barrier(const XcdBarrier& b) {
    asm volatile("s_waitcnt vmcnt(0)" ::: "memory");
    __syncthreads();
    if (b.lead && hw_lane() == 0) {
        unsigned* bar = b.bar;
        __builtin_amdgcn_s_waitcnt(0);
        unsigned nloc = b.st[0], nx = b.st[1];
        if (nloc == 0u) { xcd_barrier_complete(bar, b.x, nloc, nx); b.st[0] = nloc; b.st[1] = nx; }
        const unsigned old = xb_add(&bar[XB_XSUB(b.x)], 1u);
        const unsigned gen = old / nloc;
        if (old + 1u == (gen + 1u) * nloc) {
            __builtin_amdgcn_fence(__ATOMIC_RELEASE, "agent");
            asm volatile("s_waitcnt vmcnt(0)" ::: "memory");
            const unsigned og = xb_add(&bar[XB_TOP], 1u);
            const unsigned tg = og / nx;
            if (og + 1u == (tg + 1u) * nx) xb_add(&bar[XB_TOPGEN], 1u);
            else XB_SPIN(xb_ld(&bar[XB_TOPGEN]) == tg, bar);
            __builtin_amdgcn_fence(__ATOMIC_ACQUIRE, "agent");
            xb_add(&bar[XB_XGEN(b.x)], 1u);
            asm volatile("s_waitcnt vmcnt(0)" ::: "memory");
        } else {
            XB_SPIN(xb_ld(&bar[XB_XGEN(b.x)]) == gen, bar);
            __builtin_amdgcn_fence(__ATOMIC_ACQUIRE, "agent");
            asm volatile("s_waitcnt vmcnt(0)" ::: "memory");
        }
    }
    __syncthreads();
}

struct Args { const float* in[N_IN]; float* out; unsigned char* ws; int ph_lo, ph_hi; };
struct Frame {
    LAS unsigned char* lds;
    int tid, lane, wave, G, vcu, gw, ngw, bx;
    float* out; unsigned char* ws;
};
__device__ __forceinline__ const float* inp(int i) {
    const __attribute__((address_space(4))) char* ka = (const __attribute__((address_space(4))) char*)__builtin_amdgcn_kernarg_segment_ptr();
    asm volatile("" : "+s"(ka));
    return (const float*)(const GAS float*)*(const float* const __attribute__((address_space(4)))*)(ka + 8 * i);
}
#define FRESH(P) Frame P; { P.lds = F.lds; P.out = F.out; size_t z_ = 0; asm volatile("" : "+s"(z_)); P.ws = F.ws + z_; P.tid = launder_v(F.wave * 64 + hw_lane());     P.lane = P.tid & 63; \
    P.wave = __builtin_amdgcn_readfirstlane(P.tid >> 6); P.G = launder_s((int)gridDim.x); const int bx_ = launder_s((int)blockIdx.x); P.bx = bx_; \
    P.vcu = (P.G % 8 == 0) ? (bx_ % 8) * (P.G / 8) + bx_ / 8 : bx_; P.gw = P.vcu * 8 + P.wave; P.ngw = P.G * 8; }
#define WSP(T, off) ((T*)(F.ws + (off)))
#define F_MOD  WSP(float, WS_MOD)
#define F_ROPE WSP(float, WS_ROPE)
#define F_GDEC WSP(float, WS_GDEC)
#define F_MODP WSP(float, WS_MODP)
#define F_WIN8 WSP(unsigned char, WS_WIN)
#define F_WOUT8 WSP(unsigned char, WS_WOUT)
#define F_WMI16 WSP(bf16_t, WS_WMI)
#define F_WMI8 WSP(unsigned char, WS_WMI + WMI8_OFF)
#define F_WMO8 WSP(unsigned char, WS_WMO)
#define F_U    WSP(bf16_t, WS_U)
#define F_H8   WSP(unsigned char, WS_H)
#define F_U8   WSP(unsigned char, WS_U8)
#define F_Y8   WSP(unsigned char, WS_Y)
#define F_PROJ WSP(bf16_t, WS_PROJ)
#define F_QB   WSP(bf16_t, WS_QB)
#define F_KB   WSP(bf16_t, WS_KB)
#define F_VB   WSP(bf16_t, WS_VB)
#define F_LA   WSP(float, WS_LA)
#define F_MA8  WSP(unsigned char, WS_MA)
#define F_RKV  WSP(float, WS_RKV)
#define F_GKV  WSP(float, WS_GKV)
#define F_RSP  WSP(bf16_t, WS_RSP)
#define F_GSP  WSP(bf16_t, WS_GSP)
#define F_GA   WSP(float, WS_GA)
#define F_X    WSP(bf16_t, WS_X)
__device__ __forceinline__ int row_vec(int row) { return row < M_CTX ? 0 : 1 + ((row - M_CTX) >> 12); }

typedef short v4i16_t __attribute__((ext_vector_type(4)));
__device__ __forceinline__ bf16x8 frag_row(const LAS bf16_t* T, int LD, int idx0, int k0, int lane) {
    return *(const LAS bf16x8*)(T + (idx0 + (lane & 15)) * LD + k0 + 8 * (lane >> 4));
}
__device__ __forceinline__ bf16x8 frag_tr(const LAS bf16_t* T, int LD, int k0, int idx0, int lane) {
    const LAS bf16_t* p = T + (k0 + 8 * (lane >> 4) + ((lane >> 2) & 3)) * LD + idx0 + 4 * (lane & 3);
    const v4i16_t lo = __builtin_amdgcn_ds_read_tr16_b64_v4i16((LAS v4i16_t*)p);
    const v4i16_t hi = __builtin_amdgcn_ds_read_tr16_b64_v4i16((LAS v4i16_t*)(p + 4 * LD));
    return (bf16x8){lo[0], lo[1], lo[2], lo[3], hi[0], hi[1], hi[2], hi[3]};
}
template <int TM, int TN, bool RTR, bool CTR>
__device__ __forceinline__ void mmb(f32x4 (&acc)[TM][TN], const LAS bf16_t* R, int ldr, int r0, const LAS bf16_t* X, int ldx, int c0, int K, int lane) {
#pragma unroll 2
    for (int k0 = 0; k0 < K; k0 += 32) {
        bf16x8 fr[TM], fc[TN];
#pragma unroll
        for (int tm = 0; tm < TM; ++tm) fr[tm] = RTR ? frag_tr(R, ldr, k0, r0 + 16 * tm, lane) : frag_row(R, ldr, r0 + 16 * tm, k0, lane);
#pragma unroll
        for (int tn = 0; tn < TN; ++tn) fc[tn] = CTR ? frag_tr(X, ldx, k0, c0 + 16 * tn, lane) : frag_row(X, ldx, c0 + 16 * tn, k0, lane);
#pragma unroll
        for (int tm = 0; tm < TM; ++tm)
#pragma unroll
            for (int tn = 0; tn < TN; ++tn) acc[tm][tn] = __builtin_amdgcn_mfma_f32_16x16x32_bf16(fc[tn], fr[tm], acc[tm][tn], 0, 0, 0);
    }
}
template <int TM, int TN> __device__ __forceinline__ void zero_acc(f32x4 (&acc)[TM][TN]) {
#pragma unroll
    for (int tm = 0; tm < TM; ++tm)
#pragma unroll
        for (int tn = 0; tn < TN; ++tn) acc[tm][tn] = (f32x4){0.f, 0.f, 0.f, 0.f};
}
template <int ROWS, int COLS>
__device__ __forceinline__ void stage_f32(LAS float* dst, int LD, const float* src, size_t ld_src, int tid) {
    constexpr int C4 = COLS / 4, N4 = ROWS * C4, NB = N4 / 512;
    static_assert(N4 % 512 == 0 && NB <= 8, "stage_f32 geometry");
    f32x4 v[NB];
#pragma unroll
    for (int b = 0; b < NB; ++b) { const int idx = tid + 512 * b, r = idx / C4, c = idx - r * C4; v[b] = *(const f32x4*)(src + (size_t)r * ld_src + 4 * c); }
#pragma unroll
    for (int b = 0; b < NB; ++b) { const int idx = tid + 512 * b, r = idx / C4, c = idx - r * C4;
        LAS f32x2* d = (LAS f32x2*)(dst + r * LD + 4 * c); d[0] = (f32x2){v[b][0], v[b][1]}; d[1] = (f32x2){v[b][2], v[b][3]}; }
}
template <int ROWS, int COLS>
__device__ __forceinline__ void stage_bf16(LAS bf16_t* dst, int LD, const bf16_t* src, size_t ld_src, int tid) {
    constexpr int C8 = COLS / 8, N8 = ROWS * C8, NB = N8 / 512;
    static_assert(N8 % 512 == 0 && NB <= 8, "stage_bf16 geometry");
    u32x4 v[NB];
#pragma unroll
    for (int b = 0; b < NB; ++b) { const int idx = tid + 512 * b, r = idx / C8, c = idx - r * C8; v[b] = *(const u32x4*)(src + (size_t)r * ld_src + 8 * c); }
#pragma unroll
    for (int b = 0; b < NB; ++b) { const int idx = tid + 512 * b, r = idx / C8, c = idx - r * C8; *(LAS u32x4*)(dst + r * LD + 8 * c) = v[b]; }
}
__device__ __forceinline__ void rope8(float (&x)[8], int c8, int t, const float* ropeT) {
    const int pos = (c8 >= 8) ? (t & 63) : (t >> 6), f0 = (4 * c8) & 31;
    const f32x4 cs = *(const f32x4*)(ropeT + pos * 32 + f0), sn = *(const f32x4*)(ropeT + 2048 + pos * 32 + f0);
#pragma unroll
    for (int p = 0; p < 4; ++p) { const float a = x[2 * p], b = x[2 * p + 1]; x[2 * p] = a * cs[p] - b * sn[p]; x[2 * p + 1] = a * sn[p] + b * cs[p]; }
}

struct TItem { const float* src; unsigned char* dst; int N, K; float sc; };
__device__ __forceinline__ void titem_load(const TItem& d, f32x4 (&v)[8], int lane) {
#pragma unroll
    for (int i = 0; i < 8; ++i) v[i] = __builtin_nontemporal_load((const f32x4*)(d.src + (size_t)(8 * i + (lane >> 3)) * d.N + 4 * (lane & 7)));
}
__device__ __forceinline__ void titem_finish(const TItem& d, const f32x4 (&v)[8], LAS float* scr, int lane) {
#pragma unroll
    for (int i = 0; i < 8; ++i) { LAS float* s = scr + (8 * i + (lane >> 3)) * 33 + 4 * (lane & 7); s[0] = v[i][0]; s[1] = v[i][1]; s[2] = v[i][2]; s[3] = v[i][3]; }
    LDS_WAIT(); asm volatile("" ::: "memory");
    const int c = lane & 7;
    if (d.sc != 0.f) {
#pragma unroll
        for (int j = 0; j < 4; ++j) { const int n = (lane >> 3) + 8 * j; const LAS float* s = scr + (8 * c) * 33 + n; const float sc = d.sc;
            u32x2 o; o.x = pk4_fp8(s[0 * 33] * sc, s[1 * 33] * sc, s[2 * 33] * sc, s[3 * 33] * sc); o.y = pk4_fp8(s[4 * 33] * sc, s[5 * 33] * sc, s[6 * 33] * sc, s[7 * 33] * sc);
            *(u32x2*)(d.dst + (size_t)n * d.K + 8 * c) = o; }
    } else {
#pragma unroll
        for (int j = 0; j < 4; ++j) { const int n = (lane >> 3) + 8 * j; const LAS float* s = scr + (8 * c) * 33 + n;
            u32x4 o; o.x = pk2(s[0 * 33], s[1 * 33]); o.y = pk2(s[2 * 33], s[3 * 33]); o.z = pk2(s[4 * 33], s[5 * 33]); o.w = pk2(s[6 * 33], s[7 * 33]);
            *(u32x4*)(d.dst + ((size_t)n * d.K + 8 * c) * 2) = o; }
    }
    LDS_WAIT(); asm volatile("" ::: "memory");
}
constexpr int CV_OUT = 45056, CV_MI = 67584, CV_MO = 77888, CV_END = 81984;
__device__ __forceinline__ TItem convert_decode(Frame& F, int r) {
    TItem d;
    if (r < CV_OUT) { const int mat = r / 11264, item = r - mat * 11264, kb = item / 352, nb = item - kb * 352, n0 = 32 * nb;
        const int bj = n0 / DFF, j = n0 - bj * DFF, pn = j >> 7, cc = j & 127, drow0 = pn * 256 + bj * 128 + cc;
        d.N = 11264; d.K = 2048; d.sc = S8_WIN; d.src = inp(I_WIN) + (size_t)mat * 2048 * 11264 + (size_t)(64 * kb) * 11264 + n0; d.dst = F_WIN8 + (size_t)mat * 11264 * 2048 + (size_t)drow0 * 2048 + 64 * kb; return d; }
    if (r < CV_MI) { r -= CV_OUT; const int mat = r / 5632, item = r - mat * 5632, kb = item >> 6, nb = item & 63;
        d.N = 2048; d.K = 5632; d.sc = S8_WOUT; d.src = inp(I_WOUT) + (size_t)mat * 5632 * 2048 + (size_t)(64 * kb) * 2048 + 32 * nb; d.dst = F_WOUT8 + (size_t)mat * 2048 * 5632 + (size_t)(32 * nb) * 5632 + 64 * kb; return d; }
    if (r < CV_MO) { r -= CV_MI; const int mat = r / 5152, item = r - mat * 5152, kb = item / 161, nb = item - kb * 161;
        d.N = 5152; d.K = 2048; d.src = inp(I_MWIN) + (size_t)mat * 2048 * 5152 + (size_t)(64 * kb) * 5152 + 32 * nb;
        const int pn = nb >> 3, cc = 32 * (nb & 7); const bool f8 = (MI_F8MASK >> pn) & 1u; const int loc = __builtin_popcount((f8 ? MI_F8MASK : ~MI_F8MASK) & ((1u << pn) - 1u));
        if (f8) { d.sc = S8_WMI; d.dst = F_WMI8 + (size_t)mat * 11 * 256 * 2048 + (size_t)(loc * 256 + cc) * 2048 + 64 * kb; }
        else { d.sc = 0.f; d.dst = (unsigned char*)(F_WMI16 + (size_t)mat * 10 * 256 * 2048 + (size_t)(loc * 256 + cc) * 2048 + 64 * kb); }
        return d; }
    { r -= CV_MO; const int mat = r >> 11, item = r & 2047, kb = item >> 6, nb = item & 63;
        d.N = 2048; d.K = 2048; d.sc = S8_WMO; d.src = inp(I_MWOUT) + (size_t)mat * 2048 * 2048 + (size_t)(64 * kb) * 2048 + 32 * nb; d.dst = F_WMO8 + (size_t)mat * 2048 * 2048 + (size_t)(32 * nb) * 2048 + 64 * kb; return d; }
}
__device__ __forceinline__ void convert_ranges(Frame& F, int a0, int a1, int b0, int b1, int c0, int c1, int worker, int nworkers) {
    LAS float* scr = (LAS float*)(F.lds + F.wave * 8448);
    const int na = a1 - a0, nb = b1 - b0, nc = c1 - c0, n = na + nb + nc;
#define CV_MAP(t) ((t) < na ? a0 + (t) : ((t) < na + nb ? b0 + ((t) - na) : c0 + ((t) - na - nb)))
    for (int t = worker; t < n; t += 2 * nworkers) {
        const int t2 = t + nworkers; const bool two = t2 < n;
        const TItem d1 = convert_decode(F, CV_MAP(t)); const TItem d2 = convert_decode(F, CV_MAP(two ? t2 : t));
        f32x4 v1[8], v2[8];
        titem_load(d1, v1, F.lane); if (two) titem_load(d2, v2, F.lane);
        titem_finish(d1, v1, scr, F.lane); if (two) titem_finish(d2, v2, scr, F.lane);
    }
#undef CV_MAP
}
constexpr int CV_PRO_END = 37856;
__device__ __forceinline__ void phase_prologue_a(Frame& F) {
    constexpr int T_GEMV = 2 * 576;
    LAS float* SC = (LAS float*)(F.lds + 70656);
    for (int i = F.tid; i < 3 * 2048; i += 512) { const int v = i >> 11, k = i & 2047; SC[i] = siluf(v == 0 ? inp(I_CCTX)[k] : inp(I_C)[(v - 1) * 2048 + k]); }
    __syncthreads();
    for (int r = F.gw; r < T_GEMV; r += F.ngw) {
        const int l = r / 576, cg = r - l * 576, cl = F.lane & 7, rg = F.lane >> 3;
        const float* W = inp(I_WMOD) + (size_t)l * 2048 * 18432 + (size_t)rg * 18432 + 32 * cg + 4 * cl;
        const LAS float* c0 = SC + rg;
        f32x4 a0 = {0.f, 0.f, 0.f, 0.f}, a1 = a0, a2 = a0;
#pragma unroll 16
        for (int s = 0; s < 256; ++s) { const f32x4 w = __builtin_nontemporal_load((const f32x4*)(W + (size_t)(8 * s) * 18432));
            const float s0 = c0[8 * s], s1 = c0[2048 + 8 * s], s2 = c0[4096 + 8 * s];
            a0 = a0 + w * s0; a1 = a1 + w * s1; a2 = a2 + w * s2; }
#pragma unroll
        for (int o = 8; o < 64; o <<= 1) {
#pragma unroll
            for (int e = 0; e < 4; ++e) { a0[e] += shflx(a0[e], o); a1[e] += shflx(a1[e], o); a2[e] += shflx(a2[e], o); } }
        if (rg == 0) { const f32x4 bb = *(const f32x4*)(inp(I_BMOD) + l * 18432 + 32 * cg + 4 * cl); float* P = F_MOD + (size_t)(l * 3) * 18432 + 32 * cg + 4 * cl;
            *(f32x4*)(P) = a0 + bb; *(f32x4*)(P + 18432) = a1 + bb; *(f32x4*)(P + 2 * 18432) = a2 + bb; }
    }
    const int nfree = F.ngw - T_GEMV; const int head = nfree > 0 ? (21 * nfree < CV_PRO_END ? 21 * nfree : CV_PRO_END) : 0;
    if (F.gw >= T_GEMV) convert_ranges(F, 0, head, 0, 0, 0, 0, F.gw - T_GEMV, nfree);
    convert_ranges(F, head, CV_PRO_END, 0, 0, 0, 0, F.gw, F.ngw);
    for (int r = F.gw; r < 2 * 28; r += F.ngw) { const int mat = r / 28, t = r - mat * 28; u32x4* p = (u32x4*)(F_WMI16 + (size_t)mat * 10 * 256 * 2048 + (size_t)(9 * 256 + 32 + 8 * t) * 2048);
        for (int i = F.lane; i < 8 * 2048 / 8; i += 64) p[i] = (u32x4){0u, 0u, 0u, 0u}; }
    if (F.gw == F.ngw - 1) {
        for (int e = F.lane; e < 2048; e += 64) { const int pos = e >> 5, f = e & 31;
            const float inv = __builtin_exp2f(-(float)f * (13.287712379549449f / 32.0f));
            const float ang = (float)pos * inv;
            double tt = (double)ang * 0.15915494309189535; tt -= __builtin_rint(tt);
            F_ROPE[e] = __builtin_amdgcn_cosf((float)tt); F_ROPE[2048 + e] = __builtin_amdgcn_sinf((float)tt); }
    }
}
__device__ __forceinline__ const float* x_in_row(Frame& F, int row) { return row < M_CTX ? inp(I_XP) + (size_t)row * DM : inp(I_XS) + (size_t)(row - M_CTX) * DM; }
__device__ __forceinline__ void phase_modulate0(Frame& F) {
    LAS float* V = (LAS float*)F.lds;
    for (int i = F.tid; i < 6 * 512; i += 512) { const int k = i >> 9, c = 4 * (i & 511); const float* p = F_MOD + (size_t)(k % 3) * 18432 + (k / 3) * 2048;
        *(LAS f32x4*)(V + k * 2048 + c) = *(const f32x4*)(p + c); }
    __syncthreads();
    for (int row = F.gw; row < MT; row += F.ngw) {
        const float* x = x_in_row(F, row); const int v = row_vec(row);
        unsigned char* u = F_U8 + (size_t)row * DM;
#pragma unroll
        for (int j = 0; j < 8; ++j) { const int c = 256 * j + 4 * F.lane;
            const f32x4 xv = __builtin_nontemporal_load((const f32x4*)(x + c)), sh = *(const LAS f32x4*)(V + v * 2048 + c), sc = *(const LAS f32x4*)(V + (3 + v) * 2048 + c);
            const f32x4 o = xv * (sc + 1.0f) + sh;
            *(unsigned*)(u + c) = pk4_fp8(o[0], o[1], o[2], o[3]); }
    }
}
__device__ __forceinline__ void phase_post(Frame& F, int l, int s, float wgt, bool first, int nl, int ns) {
    LAS float* V = (LAS float*)F.lds;
    {   const float* lg = inp(I_LNG) + (size_t)(l * 3 + s) * DM; const float* lb = inp(I_LNB) + (size_t)(l * 3 + s) * DM;
        for (int i = F.tid; i < 11 * 512; i += 512) { const int k = i >> 9, c = 4 * (i & 511); const float* p;
            if (k == 0) p = lg; else if (k == 1) p = lb; else if (k < 5) p = F_MOD + (size_t)(l * 3 + (k - 2)) * 18432 + (3 * s + 2) * 2048;
            else if (k < 8) p = F_MOD + (size_t)((nl < DEPTH ? nl : 0) * 3 + (k - 5)) * 18432 + (3 * ns) * 2048; else p = F_MOD + (size_t)((nl < DEPTH ? nl : 0) * 3 + (k - 8)) * 18432 + (3 * ns + 1) * 2048;
            f32x4 val = *(const f32x4*)(p + c);
            if (k >= 2 && k < 5) val = val * (wgt * (1.0f / S8_Y)); else if (k >= 8) val = val + 1.0f;
            *(LAS f32x4*)(V + k * 2048 + c) = val; }
    }
    __syncthreads();
    const bool last = !(nl < DEPTH);
    for (int row0 = F.gw; row0 < MT; row0 += 2 * F.ngw) {
        f32x2 t[2][16]; f32x2 sum[2] = {{0.f, 0.f}, {0.f, 0.f}}; int rows[2] = {row0, row0 + F.ngw}; bool ok[2] = {true, row0 + F.ngw < MT};
#pragma unroll
        for (int q = 0; q < 2; ++q) if (ok[q]) {
            const int lane = launder_v(F.lane);
            const int row = rows[q], v = row_vec(row);
            const float* x = x_in_row(F, row); const bf16_t* xb = F_X + (size_t)row * DM;
            const unsigned char* y0 = F_Y8 + (size_t)row * DM; const unsigned char* y1 = y0 + (size_t)MT * DM;
            const bool two = F.G != 256 || ((row >> 8) % 6) >= 4;
            const LAS float* gate = V + (2 + v) * 2048;
#pragma unroll
            for (int j = 0; j < 4; ++j) { const int c = 512 * j + 8 * lane;
                f32x2 xv[4], ab[4];
                if (first) { const f32x4 x0 = *(const f32x4*)(x + c), x1 = *(const f32x4*)(x + c + 4); xv[0] = (f32x2){x0[0], x0[1]}; xv[1] = (f32x2){x0[2], x0[3]}; xv[2] = (f32x2){x1[0], x1[1]}; xv[3] = (f32x2){x1[2], x1[3]}; }
                else { const u32x4 w = *(const u32x4*)(xb + c);
#pragma unroll
                    for (int k = 0; k < 4; ++k) xv[k] = (f32x2){__uint_as_float(w[k] << 16), __uint_as_float(w[k] & 0xffff0000u)}; }
                { const u32x2 wa = *(const u32x2*)(y0 + c), wb = two ? *(const u32x2*)(y1 + c) : (u32x2){0u, 0u};
                  ab[0] = __builtin_amdgcn_cvt_pk_f32_fp8((int)wa.x, false) + __builtin_amdgcn_cvt_pk_f32_fp8((int)wb.x, false); ab[1] = __builtin_amdgcn_cvt_pk_f32_fp8((int)wa.x, true) + __builtin_amdgcn_cvt_pk_f32_fp8((int)wb.x, true);
                  ab[2] = __builtin_amdgcn_cvt_pk_f32_fp8((int)wa.y, false) + __builtin_amdgcn_cvt_pk_f32_fp8((int)wb.y, false); ab[3] = __builtin_amdgcn_cvt_pk_f32_fp8((int)wa.y, true) + __builtin_amdgcn_cvt_pk_f32_fp8((int)wb.y, true); }
                const f32x4 g0 = *(const LAS f32x4*)(gate + c), g1 = *(const LAS f32x4*)(gate + c + 4);
                const f32x2 g2[4] = {{g0[0], g0[1]}, {g0[2], g0[3]}, {g1[0], g1[1]}, {g1[2], g1[3]}};
#pragma unroll
                for (int k = 0; k < 4; ++k) { const f32x2 tv = xv[k] * ALPHA + g2[k] * ab[k]; t[q][4 * j + k] = tv; sum[q] = sum[q] + tv; } }
        }
#pragma unroll
        for (int q = 0; q < 2; ++q) if (ok[q]) {
            const int lane = launder_v(F.lane);
            const int row = rows[q], v = row_vec(row);
            const float mean = wave_sum(sum[q][0] + sum[q][1]) * (1.0f / DM); f32x2 sq = {0.f, 0.f};
#pragma unroll
            for (int e = 0; e < 16; ++e) { t[q][e] = t[q][e] - mean; sq = sq + t[q][e] * t[q][e]; }
            const float rstd = 1.0f / sqrtf(wave_sum(sq[0] + sq[1]) * (1.0f / DM) + LN_EPS);
            float* xo = F.out + (size_t)row * DM; bf16_t* xbo = F_X + (size_t)row * DM; bf16_t* u = F_U + (size_t)row * DM; unsigned char* u8 = F_U8 + (size_t)row * DM;
            const LAS float* sh_ = V + (5 + v) * 2048; const LAS float* sc_ = V + (8 + v) * 2048;
#pragma unroll
            for (int j = 0; j < 4; ++j) { const int c = 512 * j + 8 * lane;
                f32x2 o[4], m[4];
#pragma unroll
                for (int h = 0; h < 2; ++h) { const f32x4 lg4 = *(const LAS f32x4*)(V + c + 4 * h), lb4 = *(const LAS f32x4*)(V + 2048 + c + 4 * h), sh4 = *(const LAS f32x4*)(sh_ + c + 4 * h), sc4 = *(const LAS f32x4*)(sc_ + c + 4 * h);
#pragma unroll
                    for (int k = 0; k < 2; ++k) { const f32x2 lg2 = {lg4[2 * k], lg4[2 * k + 1]}, lb2 = {lb4[2 * k], lb4[2 * k + 1]}, sh2 = {sh4[2 * k], sh4[2 * k + 1]}, sc2 = {sc4[2 * k], sc4[2 * k + 1]};
                        o[2 * h + k] = (t[q][4 * j + 2 * h + k] * rstd) * lg2 + lb2; m[2 * h + k] = o[2 * h + k] * sc2 + sh2; } }
                if (last) { __builtin_nontemporal_store((f32x4){o[0][0], o[0][1], o[1][0], o[1][1]}, (f32x4*)(xo + c)); __builtin_nontemporal_store((f32x4){o[2][0], o[2][1], o[3][0], o[3][1]}, (f32x4*)(xo + c + 4)); }
                else { *(u32x4*)(xbo + c) = (u32x4){pk2(o[0][0], o[0][1]), pk2(o[1][0], o[1][1]), pk2(o[2][0], o[2][1]), pk2(o[3][0], o[3][1])};
                    if (ns == 1) *(u32x4*)(u + c) = (u32x4){pk2(m[0][0], m[0][1]), pk2(m[1][0], m[1][1]), pk2(m[2][0], m[2][1]), pk2(m[3][0], m[3][1])};
                    *(u32x2*)(u8 + c) = (u32x2){pk4_fp8(m[0][0], m[0][1], m[1][0], m[1][1]), pk4_fp8(m[2][0], m[2][1], m[3][0], m[3][1])}; } }
        }
    }
}
__device__ __forceinline__ void rope4(f32x4& v, int c, int t, const float* ropeT) {
    const int pos = (c >= 16) ? (t & 63) : (t >> 6), f0 = (2 * c) & 31;
    const f32x2 cs = *(const f32x2*)(ropeT + pos * 32 + f0), sn = *(const f32x2*)(ropeT + 2048 + pos * 32 + f0);
    const float x0 = v[0] * cs[0] - v[1] * sn[0], x1 = v[0] * sn[0] + v[1] * cs[0], x2 = v[2] * cs[1] - v[3] * sn[1], x3 = v[2] * sn[1] + v[3] * cs[1];
    v = (f32x4){x0, x1, x2, x3};
}
__device__ __forceinline__ void rope4_lds(f32x4& v, int c, int t, const LAS float* ropeT) {
    const int pos = (c >= 16) ? (t & 63) : (t >> 6), f0 = (2 * c) & 31;
    const f32x2 cs = *(const LAS f32x2*)(ropeT + pos * 32 + f0), sn = *(const LAS f32x2*)(ropeT + 2048 + pos * 32 + f0);
    const float x0 = v[0] * cs[0] - v[1] * sn[0], x1 = v[0] * sn[0] + v[1] * cs[0], x2 = v[2] * cs[1] - v[3] * sn[1], x3 = v[2] * sn[1] + v[3] * cs[1];
    v = (f32x4){x0, x1, x2, x3};
}
__device__ __forceinline__ void phase_prep(Frame& F, int l) {
    const int lane = F.lane, c32 = lane & 31;
    LAS float* WA = (LAS float*)F.lds; LAS float* BA = WA + 8192; LAS float* RT = BA + 512;
    for (int i = F.tid; i < 2048; i += 512) *(LAS f32x4*)(WA + 4 * i) = *(const f32x4*)(inp(I_WA2) + (size_t)l * 8192 + 4 * i);
    if (F.tid < 128) *(LAS f32x4*)(BA + 4 * F.tid) = *(const f32x4*)(inp(I_BA) + (size_t)l * 512 + 4 * F.tid);
    for (int i = F.tid; i < 1024; i += 512) *(LAS f32x4*)(RT + 4 * i) = *(const f32x4*)(F_ROPE + 4 * i);
    __syncthreads();
    const f32x4 qn = *(const f32x4*)(inp(I_QN) + l * 128 + 4 * c32), kn = *(const f32x4*)(inp(I_KN) + l * 128 + 4 * c32);
    for (int row = F.gw; row < MT + 512; row += F.ngw) {
        if (row >= MT) {
            const int r = row - MT, b = r >> 8, t = r & 255;
            const size_t src = ((size_t)((b * 2 + l) * 256 + t)) * 256 + 4 * lane, dst = KB_LAT_OFF + ((size_t)(b * LSEQ + t)) * 256 + 4 * lane;
            const f32x4 kv = *(const f32x4*)(inp(I_CK) + src), vv = *(const f32x4*)(inp(I_CV) + src);
            *(u32x2*)(F_KB + dst) = (u32x2){pk2(kv[0], kv[1]), pk2(kv[2], kv[3])};
            *(u32x2*)(F_VB + dst) = (u32x2){pk2(vv[0], vv[1]), pk2(vv[2], vv[3])};
            continue;
        }
        const bool lat = row >= M_CTX; const int t = (row - M_CTX) & 4095;
        const bf16_t* p = F_PROJ + (size_t)row * NPROJP;
        u32x2 aqw[4]; f32x4 gaw[8];
#pragma unroll
        for (int j = 0; j < 4; ++j) aqw[j] = *(const u32x2*)(p + C_AQ + 256 * j + 4 * lane);
        const u32x2 akw = *(const u32x2*)(p + C_AK + 4 * lane), avw = *(const u32x2*)(p + C_AV + 4 * lane);
        { const float* gp = F_GA + (size_t)row * 32;
#pragma unroll
          for (int i = 0; i < 8; ++i) gaw[i] = *(const f32x4*)(gp + 4 * i); }
#pragma unroll
        for (int j = 0; j < 4; ++j) {
            f32x4 x = bf4_to_f32(aqw[j]);
            const float ss = half_sum32((x[0] * x[0] + x[1] * x[1]) + (x[2] * x[2] + x[3] * x[3]));
            const float rs = 1.0f / sqrtf(ss * (1.0f / 128.0f) + RMS_EPS);
            x = x * rs * qn;
            if (lat) rope4_lds(x, c32, t, RT);
            *(u32x2*)(F_QB + (size_t)row * 1024 + 256 * j + 4 * lane) = (u32x2){pk2(x[0], x[1]), pk2(x[2], x[3])};
        }
        size_t kvdst; if (lat) { const int b = (row - M_CTX) >> 12; kvdst = KB_LAT_OFF + ((size_t)(b * LSEQ + 256 + t)) * 256 + 4 * lane; } else kvdst = (size_t)row * 256 + 4 * lane;
        {
            f32x4 x = bf4_to_f32(akw);
            const float ss = half_sum32((x[0] * x[0] + x[1] * x[1]) + (x[2] * x[2] + x[3] * x[3]));
            const float rs = 1.0f / sqrtf(ss * (1.0f / 128.0f) + RMS_EPS);
            x = x * rs * kn;
            if (lat) rope4_lds(x, c32, t, RT);
            *(u32x2*)(F_KB + kvdst) = (u32x2){pk2(x[0], x[1]), pk2(x[2], x[3])};
            if (!lat) { const int b = row >> 8, tt = row & 255; __builtin_nontemporal_store(x, (f32x4*)(F.out + O_K + ((size_t)((b * 2 + l) * 256 + tt)) * 256 + 4 * lane)); }
        }
        {
            *(u32x2*)(F_VB + kvdst) = avw;
            if (!lat) { const int b = row >> 8, tt = row & 255; __builtin_nontemporal_store(bf4_to_f32(avw), (f32x4*)(F.out + O_V + ((size_t)((b * 2 + l) * 256 + tt)) * 256 + 4 * lane)); }
        }
        {
#pragma unroll
            for (int d = 0; d < 2; ++d) {
                f32x4 pre = *(const LAS f32x4*)(BA + d * 256 + 4 * lane);
                const LAS float* w = WA + d * 4096 + 4 * lane;
#pragma unroll
                for (int r = 0; r < 16; ++r) pre = pre + *(const LAS f32x4*)(w + r * 256) * gaw[(16 * d + r) >> 2][(16 * d + r) & 3];
                f32x4 la;
#pragma unroll
                for (int e = 0; e < 4; ++e) { const float x = pre[e]; la[e] = (fminf(x, 0.f) - __logf(1.0f + __expf(-fabsf(x)))) * (1.0f / 16.0f); }
                *(f32x4*)(F_LA + (size_t)row * 512 + d * 256 + 4 * lane) = la;
            }
        }
    }
}

__device__ __forceinline__ void ret_l1_unit(Frame& F, int l, int u) {
    const int tid = launder_v(F.tid), lane = tid & 63;
    const int cidx = u >> 2, h = u & 3, row0 = cidx * 128; const bool lat = cidx >= 32; const int t0 = (row0 - M_CTX) & 4095;
    LAS bf16_t* Kf = (LAS bf16_t*)F.lds; LAS bf16_t* Kb = Kf + 128 * 144; LAS bf16_t* Vs = Kb + 128 * 144;
    const float lgf = inp(I_RLD)[(l * 2 + 0) * 4 + h] * 1.44269504089f, lgb = inp(I_RLD)[(l * 2 + 1) * 4 + h] * 1.44269504089f;
    const bf16_t* kp = F_PROJ + (size_t)row0 * NPROJP + C_RK + h * 128;
    __syncthreads();
    u32x4 kr[4];
#pragma unroll
    for (int b = 0; b < 4; ++b) { const int idx = tid + 512 * b, r = idx >> 4, c = idx & 15; kr[b] = *(const u32x4*)(kp + (size_t)r * NPROJP + 8 * c); }
    stage_bf16<128, 128>(Vs, 144, F_PROJ + (size_t)row0 * NPROJP + C_RV + h * 128, NPROJP, tid);
#pragma unroll
    for (int b = 0; b < 4; ++b) { const int idx = tid + 512 * b, r = idx >> 4, c = idx & 15;
        float x[8]; bf8_to_f32(kr[b], x);
#pragma unroll
        for (int e = 0; e < 8; ++e) x[e] *= 0.08838834764831845f;
        if (lat) rope8(x, c, t0 + r, F_ROPE);
        const float wf = __builtin_amdgcn_exp2f(lgf * (float)(127 - r)), wb = __builtin_amdgcn_exp2f(lgb * (float)r);
        float xf[8], xb[8];
#pragma unroll
        for (int e = 0; e < 8; ++e) { xf[e] = x[e] * wf; xb[e] = x[e] * wb; }
        *(LAS u32x4*)(Kf + r * 144 + 8 * c) = f32_to_bf8(xf); *(LAS u32x4*)(Kb + r * 144 + 8 * c) = f32_to_bf8(xb); }
    __syncthreads();
    const int w = tid >> 6, d0 = 32 * (w >> 1), e0 = 64 * (w & 1), li = lane & 15, lk = lane >> 4;
    f32x4 af[2][4], ab[2][4]; zero_acc(af); zero_acc(ab);
    mmb<2, 4, true, true>(af, Kf, 144, d0, Vs, 144, e0, 128, lane);
    mmb<2, 4, true, true>(ab, Kb, 144, d0, Vs, 144, e0, 128, lane);
    float* of = F_RKV + (size_t)(u * 2) * 16384; float* ob = of + 16384;
#pragma unroll
    for (int tm = 0; tm < 2; ++tm)
#pragma unroll
        for (int tn = 0; tn < 4; ++tn) { const int d = d0 + 16 * tm + li, e = e0 + 16 * tn + 4 * lk; *(f32x4*)(of + d * 128 + e) = af[tm][tn]; *(f32x4*)(ob + d * 128 + e) = ab[tm][tn]; }
}
__device__ __forceinline__ void gla_cumsum(LAS float* LAf, LAS float* LAb, int tid) {
    const int w = tid >> 6, lane = tid & 63;
    for (int s0 = w; s0 < 128; s0 += 32) {
        LAS float* p[4]; float v[4];
#pragma unroll
        for (int q = 0; q < 4; ++q) { const int s = s0 + 8 * q; const bool bwd = s >= 64; const int d = s & 63, j = bwd ? 63 - lane : lane; p[q] = (bwd ? LAb : LAf) + j * 66 + d; v[q] = *p[q]; }
#pragma unroll
        for (int q = 0; q < 4; ++q) v[q] = wave_prefix(v[q]);
#pragma unroll
        for (int q = 0; q < 4; ++q) *p[q] = v[q];
    }
}
__device__ __forceinline__ void gla_l1_unit(Frame& F, int l, int u) {
    const int tid = launder_v(F.tid), lane = tid & 63;
    const int cg = u >> 2, h = u & 3, row0 = cg * 64;
    LAS float* LAf = (LAS float*)F.lds; LAS float* LAb = LAf + 64 * 66;
    LAS bf16_t* Kf = (LAS bf16_t*)(LAb + 64 * 66); LAS bf16_t* Kb = Kf + 64 * 80; LAS bf16_t* Vs = Kb + 64 * 80;
    __syncthreads();
    const int kr_r = tid >> 3, kr_c = tid & 7;
    const u32x4 kr = *(const u32x4*)(F_PROJ + (size_t)(row0 + kr_r) * NPROJP + C_GK + h * 64 + 8 * kr_c);
    stage_f32<64, 64>(LAf, 66, F_LA + (size_t)row0 * 512 + h * 64, 512, tid);
    stage_f32<64, 64>(LAb, 66, F_LA + (size_t)row0 * 512 + 256 + h * 64, 512, tid);
    stage_bf16<64, 128>(Vs, 144, F_PROJ + (size_t)row0 * NPROJP + C_GV + h * 128, NPROJP, tid);
    __syncthreads();
    gla_cumsum(LAf, LAb, tid);
    __syncthreads();
#pragma unroll
    for (int b = 0; b < 2; ++b) { const int idx = tid + 512 * b, r = idx >> 4, c = idx & 15;
        float* g = F_LA + (size_t)(row0 + r) * 512 + h * 64 + 4 * c; const LAS float* sf = LAf + r * 66 + 4 * c; const LAS float* sb = LAb + r * 66 + 4 * c;
        *(f32x4*)g = (f32x4){sf[0], sf[1], sf[2], sf[3]}; *(f32x4*)(g + 256) = (f32x4){sb[0], sb[1], sb[2], sb[3]}; }
    { float x[8], xf[8], xb[8]; bf8_to_f32(kr, x);
#pragma unroll
      for (int e = 0; e < 8; ++e) { const int d = 8 * kr_c + e; xf[e] = x[e] * __expf(LAf[63 * 66 + d] - LAf[kr_r * 66 + d]); xb[e] = x[e] * __expf(LAb[d] - LAb[kr_r * 66 + d]); }
      *(LAS u32x4*)(Kf + kr_r * 80 + 8 * kr_c) = f32_to_bf8(xf); *(LAS u32x4*)(Kb + kr_r * 80 + 8 * kr_c) = f32_to_bf8(xb); }
    if (tid < 64) { F_GDEC[(size_t)(u * 2) * 64 + tid] = __expf(LAf[63 * 66 + tid]); F_GDEC[(size_t)(u * 2 + 1) * 64 + tid] = __expf(LAb[tid]); }
    __syncthreads();
    const int w = tid >> 6, d0 = 16 * (w >> 1), e0 = 64 * (w & 1), li = lane & 15, lk = lane >> 4;
    f32x4 af[1][4], ab[1][4]; zero_acc(af); zero_acc(ab);
    mmb<1, 4, true, true>(af, Kf, 80, d0, Vs, 144, e0, 64, lane);
    mmb<1, 4, true, true>(ab, Kb, 80, d0, Vs, 144, e0, 64, lane);
    float* of = F_GKV + (size_t)(u * 2) * 8192; float* ob = of + 8192;
#pragma unroll
    for (int tn = 0; tn < 4; ++tn) { const int d = d0 + li, e = e0 + 16 * tn + 4 * lk; *(f32x4*)(of + d * 128 + e) = af[0][tn]; *(f32x4*)(ob + d * 128 + e) = ab[0][tn]; }
}
template <int N, int ESZ, bool GLA>
__device__ __forceinline__ f32x4 scan_chain(f32x4 S, const float* KV, bf16_t* SP, const float* DEC, int c0, int h, int dir, int q4, float dec0) {
    constexpr int B = N < 16 ? N : 16;
    for (int st = 0; st < N; st += B) {
        f32x4 kv[B]; float dc[B]; size_t off[B];
#pragma unroll
        for (int q = 0; q < B; ++q) { const int c = dir ? N - 1 - (st + q) : st + q; const int uu = (c0 + c) * 4 + h; off[q] = ((size_t)(uu * 2 + dir)) * ESZ + 4 * q4;
            kv[q] = *(const f32x4*)(KV + off[q]); dc[q] = GLA ? DEC[(size_t)(uu * 2 + dir) * 64 + (q4 >> 5)] : dec0; }
#pragma unroll
        for (int q = 0; q < B; ++q) { *(u32x2*)(SP + off[q]) = (u32x2){pk2(S[0], S[1]), pk2(S[2], S[3])}; S = S * dc[q] + kv[q]; }
    }
    return S;
}
__device__ __forceinline__ void scan_ret_item(Frame& F, int l, int it) {
    const bool lat = it < 65536; const int it2 = lat ? it : it - 65536;
    const int chain = it2 >> 12, q4 = it2 & 4095, b = chain >> 3, h = (chain >> 1) & 3, dir = chain & 1;
    const size_t sidx = ((size_t)(((b * 2 + l) * 2 + dir) * 4 + h)) * 16384 + 4 * q4;
    const float dec = __expf(128.0f * inp(I_RLD)[(l * 2 + dir) * 4 + h]);
    if (lat) { (void)scan_chain<32, 16384, false>(*(const f32x4*)(inp(I_SR) + sidx), F_RKV, F_RSP, nullptr, 32 + 32 * b, h, dir, q4, dec); }
    else { const f32x4 S = scan_chain<2, 16384, false>((f32x4){0.f, 0.f, 0.f, 0.f}, F_RKV, F_RSP, nullptr, 2 * b, h, dir, q4, dec); __builtin_nontemporal_store(S, (f32x4*)(F.out + O_SR + sidx)); }
}
__device__ __forceinline__ void scan_gla_item(Frame& F, int l, int it) {
    const bool lat = it < 32768; const int it2 = lat ? it : it - 32768;
    const int chain = it2 >> 11, q4 = it2 & 2047, b = chain >> 3, h = (chain >> 1) & 3, dir = chain & 1;
    const size_t sidx = ((size_t)(((b * 2 + l) * 2 + dir) * 4 + h)) * 8192 + 4 * q4;
    if (lat) { (void)scan_chain<64, 8192, true>(*(const f32x4*)(inp(I_SG) + sidx), F_GKV, F_GSP, F_GDEC, 64 + 64 * b, h, dir, q4, 0.f); }
    else { const f32x4 S = scan_chain<4, 8192, true>((f32x4){0.f, 0.f, 0.f, 0.f}, F_GKV, F_GSP, F_GDEC, 4 * b, h, dir, q4, 0.f); __builtin_nontemporal_store(S, (f32x4*)(F.out + O_SG + sidx)); }
}
template <int N, int ESZ, bool GLA, int NI, int SHIFT>
__device__ __forceinline__ void scan_ctx_batch(Frame& F, int l, int it2_0, int it2_step, const float* KV, bf16_t* SP, const float* DEC, float* OUT) {
    f32x4 kv[NI][N]; float dc[NI][N];
#pragma unroll
    for (int k = 0; k < NI; ++k) { const int it2 = it2_0 + k * it2_step, chain = it2 >> SHIFT, q4 = it2 & ((1 << SHIFT) - 1), b = chain >> 3, h = (chain >> 1) & 3, dir = chain & 1;
#pragma unroll
        for (int c = 0; c < N; ++c) { const int cc = dir ? N - 1 - c : c; const int uu = (N * b + cc) * 4 + h; const size_t off = ((size_t)(uu * 2 + dir)) * ESZ + 4 * q4;
            kv[k][c] = *(const f32x4*)(KV + off); dc[k][c] = GLA ? DEC[(size_t)(uu * 2 + dir) * 64 + (q4 >> 5)] : (c == 0 ? inp(I_RLD)[(l * 2 + dir) * 4 + h] : 0.f); } }
    const float z = __builtin_bit_cast(float, launder_v(0));
#pragma unroll
    for (int k = 0; k < NI; ++k) { const int it2 = it2_0 + k * it2_step, chain = it2 >> SHIFT, q4 = it2 & ((1 << SHIFT) - 1), b = chain >> 3, h = (chain >> 1) & 3, dir = chain & 1;
        const float dec0 = GLA ? 0.f : __expf(128.0f * dc[k][0]);
        f32x4 S = {z, z, z, z};
#pragma unroll
        for (int c = 0; c < N; ++c) { const int cc = dir ? N - 1 - c : c; const int uu = (N * b + cc) * 4 + h; const size_t off = ((size_t)(uu * 2 + dir)) * ESZ + 4 * q4;
            *(u32x2*)(SP + off) = (u32x2){pk2(S[0], S[1]), pk2(S[2], S[3])}; S = S * (GLA ? dc[k][c] : dec0) + kv[k][c]; }
        __builtin_nontemporal_store(S, (f32x4*)(OUT + ((size_t)(((b * 2 + l) * 2 + dir) * 4 + h)) * ESZ + 4 * q4)); }
}
__device__ __forceinline__ void phase_scan(Frame& F, int l) {
    const int gt = F.vcu * 512 + F.tid, NT = F.G * 512;
    if (NT == 131072) {
        if (gt < 65536) { scan_ret_item(F, l, gt); scan_ctx_batch<2, 16384, false, 8, 12>(F, l, gt, 65536, F_RKV, F_RSP, nullptr, F.out + O_SR); }
        else if (gt < 98304) scan_gla_item(F, l, gt - 65536);
        else { const int g2 = gt - 98304; scan_ctx_batch<4, 8192, true, 4, 11>(F, l, g2, 32768, F_GKV, F_GSP, F_GDEC, F.out + O_SG); scan_ctx_batch<4, 8192, true, 4, 11>(F, l, g2 + 4 * 32768, 32768, F_GKV, F_GSP, F_GDEC, F.out + O_SG); }
    } else {
        for (int it = gt; it < 589824; it += NT) scan_ret_item(F, l, it);
        for (int it = gt; it < 294912; it += NT) scan_gla_item(F, l, it);
    }
}
__device__ __forceinline__ void ret_l3_unit(Frame& F, int l, int u) {
    const int tid = launder_v(F.tid), lane = tid & 63;
    const int cidx = u >> 2, h = u & 3, row0 = cidx * 128; const bool lat = cidx >= 32; const int t0 = (row0 - M_CTX) & 4095;
    LAS bf16_t* Qs = (LAS bf16_t*)F.lds; LAS bf16_t* Ks = Qs + 128 * 136; LAS bf16_t* SfV = Ks + 128 * 136; LAS bf16_t* Sbs = SfV + 128 * 144;
    LAS float* RED = (LAS float*)(F.lds + LDS_RED);
    const float lgf = inp(I_RLD)[(l * 2 + 0) * 4 + h] * 1.44269504089f, lgb = inp(I_RLD)[(l * 2 + 1) * 4 + h] * 1.44269504089f;
    const int w = tid >> 6, i0 = 32 * (w >> 1), e0 = 64 * (w & 1), wcol = w & 1, li = lane & 15, lk = lane >> 4;
    const bf16_t* pb = F_PROJ + (size_t)row0 * NPROJP + h * 128;
    __syncthreads();
    u32x2 gr[2][4];
    {
        u32x4 qr[4], kr[4];
#pragma unroll
        for (int b = 0; b < 4; ++b) { const int idx = tid + 512 * b, r = idx >> 4, c = idx & 15; qr[b] = *(const u32x4*)(pb + C_RQ + (size_t)r * NPROJP + 8 * c); kr[b] = *(const u32x4*)(pb + C_RK + (size_t)r * NPROJP + 8 * c); }
        stage_bf16<128, 128>(SfV, 144, F_RSP + (size_t)(u * 2) * 16384, 128, tid);
        stage_bf16<128, 128>(Sbs, 144, F_RSP + (size_t)(u * 2 + 1) * 16384, 128, tid);
#pragma unroll
        for (int tm = 0; tm < 2; ++tm)
#pragma unroll
            for (int tn = 0; tn < 4; ++tn) gr[tm][tn] = *(const u32x2*)(pb + (size_t)(i0 + 16 * tm + li) * NPROJP + C_RG + e0 + 16 * tn + 4 * lk);
#pragma unroll
        for (int b = 0; b < 4; ++b) { const int idx = tid + 512 * b, r = idx >> 4, c = idx & 15;
            float x[8]; bf8_to_f32(qr[b], x); if (lat) rope8(x, c, t0 + r, F_ROPE); *(LAS u32x4*)(Qs + r * 136 + 8 * c) = f32_to_bf8(x);
            bf8_to_f32(kr[b], x);
#pragma unroll
            for (int e = 0; e < 8; ++e) x[e] *= 0.08838834764831845f;
            if (lat) rope8(x, c, t0 + r, F_ROPE); *(LAS u32x4*)(Ks + r * 136 + 8 * c) = f32_to_bf8(x); }
    }
    __syncthreads();
    f32x4 out[2][4], tmp[2][4];
    zero_acc(out); mmb<2, 4, false, true>(out, Qs, 136, i0, SfV, 144, e0, 128, lane);
#pragma unroll
    for (int tm = 0; tm < 2; ++tm) { const float f = __builtin_amdgcn_exp2f(lgf * (float)(i0 + 16 * tm + li + 1));
#pragma unroll
        for (int tn = 0; tn < 4; ++tn) out[tm][tn] = out[tm][tn] * f; }
    zero_acc(tmp); mmb<2, 4, false, true>(tmp, Qs, 136, i0, Sbs, 144, e0, 128, lane);
#pragma unroll
    for (int tm = 0; tm < 2; ++tm) { const float f = __builtin_amdgcn_exp2f(lgb * (float)(128 - (i0 + 16 * tm + li)));
#pragma unroll
        for (int tn = 0; tn < 4; ++tn) out[tm][tn] = out[tm][tn] + tmp[tm][tn] * f; }
    zero_acc(tmp); mmb<2, 4, false, false>(tmp, Qs, 136, i0, Ks, 136, e0, 128, lane);
    u32x4 vr[4];
#pragma unroll
    for (int b = 0; b < 4; ++b) { const int idx = tid + 512 * b, r = idx >> 4, c = idx & 15; vr[b] = *(const u32x4*)(pb + C_RV + (size_t)r * NPROJP + 8 * c); }
    __syncthreads();
#pragma unroll
    for (int tm = 0; tm < 2; ++tm)
#pragma unroll
        for (int tn = 0; tn < 4; ++tn) { const int i = i0 + 16 * tm + li, jb = e0 + 16 * tn + 4 * lk; float pv[4];
#pragma unroll
            for (int r = 0; r < 4; ++r) { const int df = i - (jb + r);
                const float dm = df > 0 ? __builtin_amdgcn_exp2f(lgf * (float)df) : (df < 0 ? __builtin_amdgcn_exp2f(lgb * (float)(-df)) : 2.0f);
                pv[r] = tmp[tm][tn][r] * dm; }
            *(LAS u32x2*)(Ks + i * 136 + jb) = (u32x2){pk2(pv[0], pv[1]), pk2(pv[2], pv[3])}; }
#pragma unroll
    for (int b = 0; b < 4; ++b) { const int idx = tid + 512 * b, r = idx >> 4, c = idx & 15; *(LAS u32x4*)(SfV + r * 144 + 8 * c) = vr[b]; }
    __syncthreads();
    mmb<2, 4, false, true>(out, Ks, 136, i0, SfV, 144, e0, 128, lane);
    float mu[2], rs[2];
#pragma unroll
    for (int tm = 0; tm < 2; ++tm) { float s = 0.f;
#pragma unroll
        for (int tn = 0; tn < 4; ++tn) s += (out[tm][tn][0] + out[tm][tn][1]) + (out[tm][tn][2] + out[tm][tn][3]);
        s += shflx(s, 16); s += shflx(s, 32);
        if (lk == 0) RED[(i0 + 16 * tm + li) * 2 + wcol] = s; }
    __syncthreads();
#pragma unroll
    for (int tm = 0; tm < 2; ++tm) { const int i = i0 + 16 * tm + li; mu[tm] = (RED[i * 2] + RED[i * 2 + 1]) * (1.0f / 128.0f); }
    __syncthreads();
#pragma unroll
    for (int tm = 0; tm < 2; ++tm) { float q = 0.f;
#pragma unroll
        for (int tn = 0; tn < 4; ++tn)
#pragma unroll
            for (int r = 0; r < 4; ++r) { const float dd = out[tm][tn][r] - mu[tm]; q += dd * dd; }
        q += shflx(q, 16); q += shflx(q, 32);
        if (lk == 0) RED[(i0 + 16 * tm + li) * 2 + wcol] = q; }
    __syncthreads();
#pragma unroll
    for (int tm = 0; tm < 2; ++tm) { const int i = i0 + 16 * tm + li; rs[tm] = 1.0f / sqrtf((RED[i * 2] + RED[i * 2 + 1]) * (1.0f / 128.0f) + LN_EPS); }
#pragma unroll
    for (int tm = 0; tm < 2; ++tm) { const size_t row = (size_t)(row0 + i0 + 16 * tm + li);
#pragma unroll
        for (int tn = 0; tn < 4; ++tn) { const int e = e0 + 16 * tn + 4 * lk; const f32x4 g = bf4_to_f32(gr[tm][tn]);
            const f32x4 o = out[tm][tn];
            const float rq = rs[tm] * S8_MA;
            *(unsigned*)(F_MA8 + row * 2048 + 1024 + h * 128 + e) = pk4_fp8((o[0] - mu[tm]) * rq * siluf(g[0]), (o[1] - mu[tm]) * rq * siluf(g[1]), (o[2] - mu[tm]) * rq * siluf(g[2]), (o[3] - mu[tm]) * rq * siluf(g[3])); } }
}
__device__ __forceinline__ void gla_l3_unit(Frame& F, int l, int u) {
    const int tid = launder_v(F.tid), lane = tid & 63;
    const int cg = u >> 2, h = u & 3, row0 = cg * 64;
    LAS float* LAf = (LAS float*)F.lds; LAS float* LAb = LAf + 64 * 66;
    LAS bf16_t* Qf = (LAS bf16_t*)(LAb + 64 * 66); LAS bf16_t* Qb = Qf + 64 * 72; LAS bf16_t* Kf = Qb + 64 * 72; LAS bf16_t* Kb = Kf + 64 * 72;
    LAS bf16_t* Sfs = Kb + 64 * 72; LAS bf16_t* Sbs = Sfs + 64 * 144; LAS bf16_t* Vs = Sbs + 64 * 144; LAS bf16_t* Ps = Vs + 64 * 144;
    LAS float* RED = (LAS float*)(F.lds + LDS_RED);
    const int w = tid >> 6, i0 = 16 * (w >> 1), e0 = 64 * (w & 1), j0 = 32 * (w & 1), wcol = w & 1, li = lane & 15, lk = lane >> 4;
    const bf16_t* pb = F_PROJ + (size_t)row0 * NPROJP;
    __syncthreads();
    const int cr = tid >> 3, cc = tid & 7;
    const u32x4 qr = *(const u32x4*)(pb + (size_t)cr * NPROJP + C_GQ + h * 64 + 8 * cc), kr = *(const u32x4*)(pb + (size_t)cr * NPROJP + C_GK + h * 64 + 8 * cc);
    stage_f32<64, 64>(LAf, 66, F_LA + (size_t)row0 * 512 + h * 64, 512, tid);
    stage_f32<64, 64>(LAb, 66, F_LA + (size_t)row0 * 512 + 256 + h * 64, 512, tid);
    stage_bf16<64, 128>(Sfs, 144, F_GSP + (size_t)(u * 2) * 8192, 128, tid);
    stage_bf16<64, 128>(Sbs, 144, F_GSP + (size_t)(u * 2 + 1) * 8192, 128, tid);
    stage_bf16<64, 128>(Vs, 144, pb + C_GV + h * 128, NPROJP, tid);
    u32x2 gg[4]; f32x4 gnv[4];
#pragma unroll
    for (int tn = 0; tn < 4; ++tn) { const int e = e0 + 16 * tn + 4 * lk; gg[tn] = *(const u32x2*)(pb + (size_t)(i0 + li) * NPROJP + C_GR + h * 128 + e); gnv[tn] = *(const f32x4*)(inp(I_GN) + l * 128 + e); }
    __syncthreads();
    { float q[8], k[8], a[8], b[8], c[8], d[8]; bf8_to_f32(qr, q); bf8_to_f32(kr, k);
#pragma unroll
      for (int e = 0; e < 8; ++e) { const float bf = LAf[cr * 66 + 8 * cc + e], bb = LAb[cr * 66 + 8 * cc + e]; const float qs = q[e] * 0.125f;
          a[e] = qs * __expf(bf); b[e] = qs * __expf(bb); c[e] = k[e] * __expf(-bf); d[e] = k[e] * __expf(-bb); }
      *(LAS u32x4*)(Qf + cr * 72 + 8 * cc) = f32_to_bf8(a); *(LAS u32x4*)(Qb + cr * 72 + 8 * cc) = f32_to_bf8(b);
      *(LAS u32x4*)(Kf + cr * 72 + 8 * cc) = f32_to_bf8(c); *(LAS u32x4*)(Kb + cr * 72 + 8 * cc) = f32_to_bf8(d); }
    __syncthreads();
    f32x4 out[1][4], sf[1][2], sb[1][2];
    zero_acc(out); zero_acc(sf); zero_acc(sb);
    mmb<1, 4, false, true>(out, Qf, 72, i0, Sfs, 144, e0, 64, lane);
    mmb<1, 4, false, true>(out, Qb, 72, i0, Sbs, 144, e0, 64, lane);
    mmb<1, 2, false, false>(sf, Qf, 72, i0, Kf, 72, j0, 64, lane);
    mmb<1, 2, false, false>(sb, Qb, 72, i0, Kb, 72, j0, 64, lane);
#pragma unroll
    for (int tn = 0; tn < 2; ++tn) { const int i = i0 + li, jb = j0 + 16 * tn + 4 * lk; float pv[4];
#pragma unroll
        for (int r = 0; r < 4; ++r) { const int j = jb + r; pv[r] = (j <= i ? sf[0][tn][r] : 0.f) + (j >= i ? sb[0][tn][r] : 0.f); }
        *(LAS u32x2*)(Ps + i * 72 + jb) = (u32x2){pk2(pv[0], pv[1]), pk2(pv[2], pv[3])}; }
    __syncthreads();
    mmb<1, 4, false, true>(out, Ps, 72, i0, Vs, 144, e0, 64, lane);
    { float q = 0.f;
#pragma unroll
      for (int tn = 0; tn < 4; ++tn)
#pragma unroll
          for (int r = 0; r < 4; ++r) q += out[0][tn][r] * out[0][tn][r];
      q += shflx(q, 16); q += shflx(q, 32);
      if (lk == 0) RED[(i0 + li) * 2 + wcol] = q; }
    __syncthreads();
    const float rs = 1.0f / sqrtf((RED[(i0 + li) * 2] + RED[(i0 + li) * 2 + 1]) * (1.0f / 128.0f) + RMS_EPS);
    const size_t row = (size_t)(row0 + i0 + li);
#pragma unroll
    for (int tn = 0; tn < 4; ++tn) { const int e = e0 + 16 * tn + 4 * lk; const f32x4 g = bf4_to_f32(gg[tn]);
        const f32x4 gn = gnv[tn]; const f32x4 o = out[0][tn];
        const float rq = rs * S8_MA;
        *(unsigned*)(F_MA8 + row * 2048 + 1536 + h * 128 + e) = pk4_fp8(o[0] * rq * gn[0] * siluf(g[0]), o[1] * rq * gn[1] * siluf(g[1]), o[2] * rq * gn[2] * siluf(g[2]), o[3] * rq * gn[3] * siluf(g[3])); }
}
__device__ __forceinline__ void attn_any_unit(Frame& F, int c) {
    size_t qrow, kvoff; int h, kvh, seq;
    if (c < 256) { const int x = c & 7, idx = c >> 3, combo = x >> 1, sub = (x & 1) * 32 + idx, g = sub >> 4, qb = sub & 15, b = combo >> 1; kvh = combo & 1; h = kvh * 4 + g;
        qrow = (size_t)(M_CTX + b * 4096 + qb * 256); kvoff = KB_LAT_OFF + (size_t)b * LSEQ * 256; seq = LSEQ; }
    else { const int cc = c - 256, b = cc >> 3; h = cc & 7; kvh = h >> 2; qrow = (size_t)b * 256; kvoff = qrow * 256; seq = 256; }
    __syncthreads();
    att::attn_unit(F_QB + qrow * 1024 + h * 128, F_KB + kvoff + kvh * 128, F_VB + kvoff + kvh * 128, F_MA8 + qrow * 2048 + h * 128, seq, (char*)F.lds, launder_v(F.tid));
}

constexpr int N_PHASES = 2 + 13 * DEPTH;
__global__ void __launch_bounds__(512, 2) mk_fwd(Args args) {
    extern __shared__ __attribute__((aligned(16))) unsigned char lds_raw[];
    asm volatile("s_nop 0\n\ts_nop 0\n\ts_nop 0\n\ts_nop 0");
    Frame F;
    F.lds = (LAS unsigned char*)lds_raw;
    F.tid = threadIdx.x; F.lane = 0; F.wave = __builtin_amdgcn_readfirstlane((int)threadIdx.x >> 6); F.G = 0; F.vcu = 0; F.gw = 0; F.ngw = 0; F.bx = 0;
    F.out = (float*)(GAS float*)args.out; F.ws = (unsigned char*)(GAS unsigned char*)args.ws;
    unsigned char* ws = args.ws;
    volatile LAS unsigned* MISC = (volatile LAS unsigned*)(F.lds + LDS_MISC);
    if (F.tid < 64) MISC[F.tid] = 0u;
    __syncthreads();
    const int lo = args.ph_lo, hi = args.ph_hi;
    unsigned* barw = (unsigned*)(ws + WS_CTL) + CW_BAR;
    XcdBarrier bar; bar.bar = barw; bar.x = 0; bar.st = MISC + 8; bar.lead = (F.wave == 0);
    if (hi - lo > 1) bar = xcd_barrier_post(barw, MISC + 8, F.wave == 0);
#ifndef PROBE_DUP
#define PROBE_DUP 0
#endif
#define DUP(bit, ...) do { __VA_ARGS__; if ((PROBE_DUP >> (bit)) & 1) { __syncthreads(); __VA_ARGS__; } } while (0)
#define IN(k) (lo <= (k) && (k) < hi)
#define SEAM(k) do { if ((k) + 1 < hi) xcd_barrier(bar); } while (0)
    if (IN(0)) { DUP(0, { FRESH(P); phase_prologue_a(P); }); SEAM(0); }
    if (IN(1)) { FRESH(P); phase_modulate0(P); SEAM(1); }
    for (int l = 0; l < DEPTH; ++l) {
        const int p0 = 2 + 13 * l;
#define GEMM_SITE(F8_, Ap, Bp, lda_, nt_, nN_, KS_, ...) do { FRESH(P); { Frame& F = P; pg8::Gemm g{(const bf16_t*)(Ap), (const bf16_t*)(Bp), lda_, lda_, nt_}; pg8::Order S; S.init(48, nN_, KS_, P.G, P.bx); __VA_ARGS__; pg8::gemm_phase<F8_>(P.lds, g, S, E, P.tid); } } while (0)
        if (IN(p0 + 0)) { DUP(1, GEMM_SITE(true, F_U8, F_WIN8 + (size_t)(l * 2 + 0) * 11264 * 2048, DM / 2, 16, 44, 1, pg8::EpiSwiGLU8 E{F_H8, DFF}));
            { FRESH(P); if (P.bx >= 64) { const int wk = (P.bx - 64) * 8 + P.wave, nw = (P.G - 64) * 8;
                if (l == 0) convert_ranges(P, CV_OUT, CV_OUT + 5632, CV_MI, CV_MI + 5152, CV_MO, CV_MO + 2048, wk, nw);
                else convert_ranges(P, CV_OUT + 2 * 5632, CV_OUT + 3 * 5632, CV_PRO_END, CV_OUT, 0, 0, wk, nw); } }
            SEAM(p0 + 0); }
        if (IN(p0 + 1)) { DUP(2, GEMM_SITE(true, F_H8, F_WOUT8 + (size_t)(l * 2 + 0) * 2048 * 5632, DFF / 2, 22, 8, 2, pg8::EpiFp8 E{F_Y8, DM, (size_t)MT * DM, S8_Y / (S8_H * S8_WOUT)})); SEAM(p0 + 1); }
        if (IN(p0 + 2)) { FRESH(P); phase_post(P, l, 0, 0.5f, l == 0, l, 1); SEAM(p0 + 2); }
        if (IN(p0 + 3)) {
            DUP(3, { GEMM_SITE(false, F_U, F_WMI16 + (size_t)l * 10 * 256 * 2048, DM, 32, 10, 1, pg8::EpiProj E{F_PROJ, NPROJP, F_GA, MI_B16TBL, 1.0f});
                     do { FRESH(P); { Frame& F = P; pg8::Gemm g{(const bf16_t*)F_U8, (const bf16_t*)(F_WMI8 + (size_t)l * 11 * 256 * 2048), DM / 2, DM / 2, 16}; pg8::Order S; S.init(48, 11, 1, P.G, (P.bx + 32) % P.G);
                         pg8::EpiProj E{F_PROJ, NPROJP, F_GA, MI_F8TBL, 1.0f / S8_WMI}; pg8::gemm_phase<true>(P.lds, g, S, E, P.tid); } } while (0); });
            SEAM(p0 + 3); }
        if (IN(p0 + 4)) { DUP(4, { FRESH(P); phase_prep(P, l); }); DUP(5, { FRESH(P); for (int u = P.vcu; u < 384; u += P.G) ret_l1_unit(P, l, u); }); SEAM(p0 + 4); }
        if (IN(p0 + 5)) { DUP(6, { FRESH(P); for (int c = P.bx; c < 384; c += P.G) attn_any_unit(P, c); });
                          DUP(7, { FRESH(P); for (int u = P.vcu; u < 768; u += P.G) gla_l1_unit(P, l, u); }); SEAM(p0 + 5); }
        if (IN(p0 + 6)) { DUP(13, { FRESH(P); phase_scan(P, l); }); SEAM(p0 + 6); }
        if (IN(p0 + 7)) { DUP(8, { FRESH(P); for (int u = P.vcu; u < 384; u += P.G) ret_l3_unit(P, l, u); });
                          DUP(9, { FRESH(P); for (int u = P.vcu; u < 768; u += P.G) gla_l3_unit(P, l, u); }); SEAM(p0 + 7); }
        if (IN(p0 + 8)) { DUP(10, GEMM_SITE(true, F_MA8, F_WMO8 + (size_t)l * 2048 * 2048, DM / 2, 8, 8, 2, pg8::EpiFp8 E{F_Y8, DM, (size_t)MT * DM, S8_Y / (S8_MA * S8_WMO)})); SEAM(p0 + 8); }
        if (IN(p0 + 9)) { FRESH(P); phase_post(P, l, 1, 1.0f, false, l, 2); SEAM(p0 + 9); }
        if (IN(p0 + 10)) { DUP(1, GEMM_SITE(true, F_U8, F_WIN8 + (size_t)(l * 2 + 1) * 11264 * 2048, DM / 2, 16, 44, 1, pg8::EpiSwiGLU8 E{F_H8, DFF}));
            { FRESH(P); if (P.bx >= 64) { const int wk = (P.bx - 64) * 8 + P.wave, nw = (P.G - 64) * 8;
                if (l == 0) convert_ranges(P, CV_OUT + 5632, CV_OUT + 2 * 5632, CV_MI + 5152, CV_MO, CV_MO + 2048, CV_END, wk, nw);
                else convert_ranges(P, CV_OUT + 3 * 5632, CV_MI, 0, 0, 0, 0, wk, nw); } }
            SEAM(p0 + 10); }
        if (IN(p0 + 11)) { DUP(2, GEMM_SITE(true, F_H8, F_WOUT8 + (size_t)(l * 2 + 1) * 2048 * 5632, DFF / 2, 22, 8, 2, pg8::EpiFp8 E{F_Y8, DM, (size_t)MT * DM, S8_Y / (S8_H * S8_WOUT)})); SEAM(p0 + 11); }
        if (IN(p0 + 12)) { FRESH(P); phase_post(P, l, 2, 0.5f, false, l + 1, 0); SEAM(p0 + 12); }
    }
#undef IN
#undef SEAM
}

#ifndef MK_PER_PHASE
#define MK_PER_PHASE 0
#endif
extern "C" void kernel_launch(void* const* d_in, const int* in_sizes, int n_in, void* d_out, int out_size, void* d_ws, size_t ws_size, hipStream_t stream) {
    static int grid = 0;
    if (grid == 0) {
        if (n_in != N_IN || out_size != (int)O_END || ws_size < WS_END) { fprintf(stderr, "kernel_launch: shape mismatch (n_in %d out %d ws %zu, need %d %zu %zu)\n", n_in, out_size, ws_size, (int)N_IN, (size_t)O_END, (size_t)WS_END); grid = -1; return; }
        int dev = 0, cus = 0, per_cu = 0;
        if (hipGetDevice(&dev) != hipSuccess || hipDeviceGetAttribute(&cus, hipDeviceAttributeMultiprocessorCount, dev) != hipSuccess) { grid = -1; return; }
        if (hipFuncSetAttribute((const void*)mk_fwd, hipFuncAttributeMaxDynamicSharedMemorySize, LDS_BYTES) != hipSuccess) { fprintf(stderr, "kernel_launch: hipFuncSetAttribute(%d) failed\n", LDS_BYTES); grid = -1; return; }
        if (hipOccupancyMaxActiveBlocksPerMultiprocessor(&per_cu, (const void*)mk_fwd, 512, LDS_BYTES) != hipSuccess || per_cu < 1) fprintf(stderr, "kernel_launch: occupancy query reports %d\n", per_cu);
        (void)hipGetLastError();
        grid = cus;
    }
    if (grid < 0) return;
    if (hipMemsetAsync((char*)d_ws + WS_CTL, 0, CTL_ZERO_BYTES, stream) != hipSuccess) return;
    Args a{};
    for (int i = 0; i < N_IN; ++i) a.in[i] = (const float*)d_in[i];
    a.out = (float*)d_out; a.ws = (unsigned char*)d_ws;
#if MK_PER_PHASE
    for (int p = 0; p < N_PHASES; ++p) { a.ph_lo = p; a.ph_hi = p + 1; hipLaunchKernelGGL(mk_fwd, dim3(grid), dim3(512), LDS_BYTES, stream, a); }
#else
    a.ph_lo = 0; a.ph_hi = N_PHASES;
    hipLaunchKernelGGL(mk_fwd, dim3(grid), dim3(512), LDS_BYTES, stream, a);
#endif
    const hipError_t le = hipPeekAtLastError();
    if (le != hipSuccess) fprintf(stderr, "kernel_launch: launch failed: %s\n", hipGetErrorName(le));
}
```

```cpp
#include <hip/hip_runtime.h>
#include <cstdio>
#include <cstdint>

#define LAS __attribute__((address_space(3)))
#define GAS __attribute__((address_space(1)))
typedef unsigned short bf16_t;
typedef short bf16x8 __attribute__((ext_vector_type(8)));
typedef short s16x4 __attribute__((ext_vector_type(4)));
typedef float f32x2 __attribute__((ext_vector_type(2)));
typedef float f32x4 __attribute__((ext_vector_type(4)));
typedef float f32x16 __attribute__((ext_vector_type(16)));
typedef unsigned u32x2 __attribute__((ext_vector_type(2)));
typedef unsigned u32x4 __attribute__((ext_vector_type(4)));

constexpr int DM = 2048, M_CTX = 4096, M_LAT = 8192, MT = 12288, DFF = 5632, NPROJP = 5376, DEPTH = 2;
constexpr int C_AQ = 0, C_AK = 1024, C_AV = 1280, C_RQ = 1536, C_RK = 2048, C_RV = 2560, C_RG = 3072, C_GQ = 3584, C_GK = 3840, C_GV = 4096, C_GR = 4608, C_GA = 5120;
constexpr size_t O_YP = 0, O_K = 25165824, O_V = 27262976, O_SR = 29360128, O_SG = 33554432, O_END = 35651584;
constexpr float LN_EPS = 1e-5f, RMS_EPS = 1e-6f, ALPHA = 1.41421356237309515f;
constexpr int LSEQ = 4352;
enum { I_XP = 0, I_XS, I_C, I_CK, I_CV, I_SR, I_SG, I_CCTX, I_WMOD, I_BMOD, I_LNG, I_LNB, I_WIN, I_WOUT, I_MWIN, I_MWOUT, I_QN, I_KN, I_RLD, I_WA2, I_BA, I_GN, N_IN };

constexpr size_t MiB = 1u << 20;
constexpr size_t WS_CTL = 0, CTL_ZERO_BYTES = 1 * MiB;
constexpr size_t WS_MOD = 1 * MiB, WS_ROPE = 2 * MiB, WS_GDEC = 3 * MiB, WS_MODP = 4 * MiB;
constexpr size_t WS_WIN = 11 * MiB, WS_WOUT = WS_WIN + 176 * MiB, WS_WMI = WS_WOUT + 88 * MiB, WS_WMO = WS_WMI + 42 * MiB;
constexpr size_t WS_U = WS_WMO + 16 * MiB, WS_H = WS_U + 48 * MiB, WS_Y = WS_H + 132 * MiB, WS_PROJ = WS_Y + 192 * MiB;
constexpr size_t WS_QB = WS_PROJ + 252 * MiB, WS_KB = WS_QB + 24 * MiB, WS_VB = WS_KB + 7 * MiB, WS_LA = WS_VB + 7 * MiB;
constexpr size_t WS_MA = WS_LA + 24 * MiB, WS_RKV = WS_MA + 48 * MiB, WS_GKV = WS_RKV + 48 * MiB, WS_RSP = WS_GKV + 48 * MiB, WS_GSP = WS_RSP + 24 * MiB, WS_GA = WS_GSP + 24 * MiB, WS_X = WS_GA + 2 * MiB, WS_U8 = WS_X + 48 * MiB, WS_END = WS_U8 + 24 * MiB;
constexpr unsigned MI_F8MASK = (1u << 0) | (1u << 1) | (1u << 2) | (1u << 3) | (1u << 6) | (1u << 7) | (1u << 12) | (1u << 13) | (1u << 14) | (1u << 18) | (1u << 19);
constexpr unsigned long long MI_F8TBL = 0ull | (1ull << 5) | (2ull << 10) | (3ull << 15) | (6ull << 20) | (7ull << 25) | (12ull << 30) | (13ull << 35) | (14ull << 40) | (18ull << 45) | (19ull << 50);
constexpr unsigned long long MI_B16TBL = 4ull | (5ull << 5) | (8ull << 10) | (9ull << 15) | (10ull << 20) | (11ull << 25) | (15ull << 30) | (16ull << 35) | (17ull << 40) | (20ull << 45);
constexpr size_t WMI8_OFF = 24 * MiB;
constexpr size_t KB_LAT_OFF = (size_t)16 * 256 * 256;
constexpr int CW_BAR = 4096;

constexpr int LDS_MAIN = 147456;
constexpr int LDS_RED = LDS_MAIN;
constexpr int LDS_MISC = LDS_MAIN + 4096;
constexpr int LDS_BYTES = 155648;

__device__ __forceinline__ int hw_lane() { int l; asm volatile("v_mbcnt_lo_u32_b32 %0, -1, 0\n\tv_mbcnt_hi_u32_b32 %0, -1, %0" : "=v"(l)); return l; }
__device__ __forceinline__ float shflx(float v, int m) { return __builtin_bit_cast(float, __builtin_amdgcn_ds_bpermute((hw_lane() ^ m) << 2, __builtin_bit_cast(int, v))); }
__device__ __forceinline__ unsigned f2bf(float f) { unsigned u = __builtin_bit_cast(unsigned, f); return (u + 0x7fffu + ((u >> 16) & 1u)) >> 16; }
__device__ __forceinline__ unsigned pk2(float lo, float hi) { unsigned r; asm("v_cvt_pk_bf16_f32 %0, %1, %2" : "=v"(r) : "v"(lo), "v"(hi)); return r; }
__device__ __forceinline__ unsigned cvt_pk_bf16(float lo, float hi) { unsigned r; asm volatile("v_cvt_pk_bf16_f32 %0, %1, %2" : "=v"(r) : "v"(lo), "v"(hi)); return r; }
__device__ __forceinline__ float siluf(float x) { return x * __builtin_amdgcn_rcpf(1.0f + __builtin_amdgcn_exp2f(-1.44269504089f * x)); }
template <int CTRL, int RM> __device__ __forceinline__ float dpp_acc(float v) { return v + __builtin_bit_cast(float, __builtin_amdgcn_update_dpp(0, __builtin_bit_cast(int, v), CTRL, RM, 0xf, false)); }
__device__ __forceinline__ float wave_prefix(float v) {
    v = dpp_acc<0x111, 0xf>(v); v = dpp_acc<0x112, 0xf>(v); v = dpp_acc<0x114, 0xf>(v); v = dpp_acc<0x118, 0xf>(v);
    v = dpp_acc<0x142, 0xa>(v); v = dpp_acc<0x143, 0xc>(v); return v;
}
__device__ __forceinline__ float wave_sum(float v) { return __builtin_bit_cast(float, __builtin_amdgcn_readlane(__builtin_bit_cast(int, wave_prefix(v)), 63)); }
__device__ __forceinline__ float half_sum32(float v) {
#pragma unroll
    for (int o = 1; o < 32; o <<= 1) v += shflx(v, o);
    return v;
}
__device__ __forceinline__ float grp_sum16(float v) {
#pragma unroll
    for (int o = 1; o < 16; o <<= 1) v += shflx(v, o);
    return v;
}
__device__ __forceinline__ f32x4 bf4_to_f32(u32x2 w) { return (f32x4){__uint_as_float(w.x << 16), __uint_as_float(w.x & 0xffff0000u), __uint_as_float(w.y << 16), __uint_as_float(w.y & 0xffff0000u)}; }
typedef int v4i_t __attribute__((ext_vector_type(4)));
typedef int v8i_t __attribute__((ext_vector_type(8)));
__device__ __forceinline__ unsigned pk4_fp8(float a, float b, float c, float d) {
    a = __builtin_amdgcn_fmed3f(a, -448.f, 448.f); b = __builtin_amdgcn_fmed3f(b, -448.f, 448.f); c = __builtin_amdgcn_fmed3f(c, -448.f, 448.f); d = __builtin_amdgcn_fmed3f(d, -448.f, 448.f);
    int w = 0; w = __builtin_amdgcn_cvt_pk_fp8_f32(a, b, w, false); w = __builtin_amdgcn_cvt_pk_fp8_f32(c, d, w, true); return (unsigned)w;
}
constexpr float S8_WIN = 64.f, S8_WOUT = 256.f, S8_H = 4.f, S8_WMO = 128.f, S8_MA = 4.f, S8_WMI = 64.f, S8_Y = 64.f;
__device__ __forceinline__ void bf8_to_f32(u32x4 w, float (&x)[8]) {
    x[0] = __uint_as_float(w.x << 16); x[1] = __uint_as_float(w.x & 0xffff0000u); x[2] = __uint_as_float(w.y << 16); x[3] = __uint_as_float(w.y & 0xffff0000u);
    x[4] = __uint_as_float(w.z << 16); x[5] = __uint_as_float(w.z & 0xffff0000u); x[6] = __uint_as_float(w.w << 16); x[7] = __uint_as_float(w.w & 0xffff0000u);
}
__device__ __forceinline__ u32x4 f32_to_bf8(const float (&x)[8]) { return (u32x4){pk2(x[0], x[1]), pk2(x[2], x[3]), pk2(x[4], x[5]), pk2(x[6], x[7])}; }
#define LDS_WAIT() asm volatile("s_waitcnt lgkmcnt(0)" ::: "memory")

__device__ __forceinline__ int launder_v(int x) { asm volatile("" : "+v"(x)); return x; }
__device__ __forceinline__ int launder_s(int x) { asm volatile("" : "+s"(x)); return x; }
namespace pg8 {
constexpr int BM = 256, BK = 64, HALF = 128, HTB = HALF * BK * 2, STAGE_BYTES = 8 * HTB, NXCD = 8, WGM = 8;
__host__ __device__ __forceinline__ int lds_byte(int r, int c) { const int st = (r >> 4) * 2 + (c >> 5), rr = r & 15, cc = c & 31, ob = rr * 64 + cc * 2; return st * 1024 + (ob ^ (((ob >> 9) & 1) << 5)); }
__host__ __device__ __forceinline__ void stage_rc(int b, int& R, int& C) { const int st = b / 1024, sb = b % 1024, swz = sb ^ (((sb >> 9) & 1) << 5); R = (st >> 1) * 16 + swz / 64; C = (st & 1) * 32 + (swz % 64) / 2; }
__host__ __device__ __forceinline__ int perm32(int rho) { const int n = rho >> 4, i = rho & 15; return 8 * (i >> 2) + 4 * n + (i & 3); }

struct Unit { int pm, pn, ks, k0, nt; };
struct Gemm { const bf16_t* A; const bf16_t* Bt; int lda, ldb, nt; };
struct Order {
    int nM, nN, nNx, nwg, G, c; bool m15;
    __device__ void init(int nM_, int nN_, int KS, int G_, int c_) { nM = nM_; nN = nN_; nNx = nN_ * KS; nwg = nM * nNx; G = G_; c = c_; m15 = (KS == 2 && G_ == 256 && nM_ == 48 && nN_ == 8); }
    __device__ bool next(int i, Unit& u, int nt) const {
        if (m15) {
            if (i > 1) return false;
            const int x = c & 7, j = c >> 3;
            if (i == 0) { u.pm = 6 * x + (j >> 3); u.pn = j & 7; u.ks = 0; u.k0 = 0; u.nt = 2 * nt; }
            else { const int ks = j & 1, q = j >> 1, P = (x >> 1) * 4 + (q >> 2); u.pm = 6 * (P >> 1) + 4 + (P & 1); u.pn = (x & 1) * 4 + (q & 3); u.ks = ks; u.k0 = ks * nt; u.nt = nt; }
            return true;
        }
        const long L = (long)i * G + c; if (L >= nwg) return false;
        int wgid = (int)L; { const int q = nwg / NXCD, r = nwg % NXCD, xcd = wgid % NXCD, off = wgid / NXCD; wgid = (xcd < r ? xcd * (q + 1) : r * (q + 1) + (xcd - r) * q) + off; }
        const int nig = WGM * nNx, gid = wgid / nig, fm = gid * WGM, gsz = (nM - fm) < WGM ? (nM - fm) : WGM;
        u.pm = fm + ((wgid % nig) % gsz); const int pnx = (wgid % nig) / gsz; u.ks = pnx / nN; u.pn = pnx - u.ks * nN; u.k0 = u.ks * nt; u.nt = nt; return true;
    }
};
struct EpiF32 {
    static constexpr bool PERM = false;
    float* C; int ldc; size_t ks_stride;
    __device__ __forceinline__ void operator()(const f32x4 (&acc)[2][2][4][2], const Unit& u, int wr, int wc, int fr, int fq) const {
        const int row0 = u.pm * BM + wr * 64 + fr, col0 = u.pn * BM + wc * 32 + 4 * fq;
        float* Cb = C + (size_t)u.ks * ks_stride;
#pragma unroll
        for (int ai = 0; ai < 2; ++ai)
#pragma unroll
            for (int m = 0; m < 4; ++m) { float* rowp = Cb + (size_t)(row0 + ai * HALF + m * 16) * ldc + col0;
#pragma unroll
                for (int bj = 0; bj < 2; ++bj)
#pragma unroll
                    for (int n = 0; n < 2; ++n) *(f32x4*)(rowp + bj * HALF + n * 16) = acc[ai][bj][m][n]; }
    }
};
struct EpiBf16 {
    static constexpr bool PERM = true;
    bf16_t* O; int ldc; size_t ks_stride; float scale;
    __device__ __forceinline__ void operator()(const f32x4 (&acc)[2][2][4][2], const Unit& u, int wr, int wc, int fr, int fq) const {
        const int row0 = u.pm * BM + wr * 64 + fr, col0 = u.pn * BM + wc * 32 + 8 * fq;
        bf16_t* Ob = O + (size_t)u.ks * ks_stride;
#pragma unroll
        for (int ai = 0; ai < 2; ++ai)
#pragma unroll
            for (int m = 0; m < 4; ++m) { bf16_t* rowp = Ob + (size_t)(row0 + ai * HALF + m * 16) * ldc + col0;
#pragma unroll
                for (int bj = 0; bj < 2; ++bj) { const f32x4 v0 = acc[ai][bj][m][0] * scale, v1 = acc[ai][bj][m][1] * scale;
                    u32x4 w; w.x = cvt_pk_bf16(v0[0], v0[1]); w.y = cvt_pk_bf16(v0[2], v0[3]); w.z = cvt_pk_bf16(v1[0], v1[1]); w.w = cvt_pk_bf16(v1[2], v1[3]);
                    *(u32x4*)(rowp + bj * HALF) = w; } }
    }
};
struct EpiFp8 {
    static constexpr bool PERM = true;
    unsigned char* O; int ldc; size_t ks_stride; float scale;
    __device__ __forceinline__ void operator()(const f32x4 (&acc)[2][2][4][2], const Unit& u, int wr, int wc, int fr, int fq) const {
        const int row0 = u.pm * BM + wr * 64 + fr, col0 = u.pn * BM + wc * 32 + 8 * fq;
        unsigned char* Ob = O + (size_t)u.ks * ks_stride;
#pragma unroll
        for (int ai = 0; ai < 2; ++ai)
#pragma unroll
            for (int m = 0; m < 4; ++m) { unsigned char* rowp = Ob + (size_t)(row0 + ai * HALF + m * 16) * ldc + col0;
#pragma unroll
                for (int bj = 0; bj < 2; ++bj) { const f32x4 v0 = acc[ai][bj][m][0] * scale, v1 = acc[ai][bj][m][1] * scale;
                    *(u32x2*)(rowp + bj * HALF) = (u32x2){pk4_fp8(v0[0], v0[1], v0[2], v0[3]), pk4_fp8(v1[0], v1[1], v1[2], v1[3])}; } }
    }
};
struct EpiProj {
    static constexpr bool PERM = true;
    bf16_t* O; int ldc; float* GA; unsigned long long tbl; float scale;
    __device__ __forceinline__ void operator()(const f32x4 (&acc)[2][2][4][2], const Unit& u, int wr, int wc, int fr, int fq) const {
        const int gpn = (int)((tbl >> (5 * u.pn)) & 31ull);
        const int row0 = u.pm * BM + wr * 64 + fr, col0 = gpn * BM + wc * 32 + 8 * fq;
        if (gpn == 20) {
            if (wc == 0) {
#pragma unroll
                for (int ai = 0; ai < 2; ++ai)
#pragma unroll
                    for (int m = 0; m < 4; ++m) { float* g = GA + (size_t)(row0 + ai * HALF + m * 16) * 32 + 8 * fq;
                        *(f32x4*)g = acc[ai][0][m][0] * scale; *(f32x4*)(g + 4) = acc[ai][0][m][1] * scale; }
            }
            return;
        }
#pragma unroll
        for (int ai = 0; ai < 2; ++ai)
#pragma unroll
            for (int m = 0; m < 4; ++m) { bf16_t* rowp = O + (size_t)(row0 + ai * HALF + m * 16) * ldc + col0;
#pragma unroll
                for (int bj = 0; bj < 2; ++bj) { const f32x4 v0 = acc[ai][bj][m][0] * scale, v1 = acc[ai][bj][m][1] * scale;
                    u32x4 w; w.x = cvt_pk_bf16(v0[0], v0[1]); w.y = cvt_pk_bf16(v0[2], v0[3]); w.z = cvt_pk_bf16(v1[0], v1[1]); w.w = cvt_pk_bf16(v1[2], v1[3]);
                    *(u32x4*)(rowp + bj * HALF) = w; } }
    }
};
struct EpiSwiGLU8 {
    static constexpr bool PERM = true;
    unsigned char* H; int ldc;
    __device__ __forceinline__ void operator()(const f32x4 (&acc)[2][2][4][2], const Unit& u, int wr, int wc, int fr, int fq) const {
        const int row0 = u.pm * BM + wr * 64 + fr, col0 = u.pn * HALF + wc * 32 + 8 * fq;
        constexpr float DS = 1.0f / S8_WIN;
        f32x2 kc; asm volatile("v_mov_b32 %0, %1" : "=v"(kc[0]) : "s"(-DS * 1.44269504089f)); asm volatile("v_mov_b32 %0, %1" : "=v"(kc[1]) : "s"(1.0f / (DS * DS * S8_H)));
        const f32x4 c1v = {kc[0], kc[0], kc[0], kc[0]}, ic2v = {kc[1], kc[1], kc[1], kc[1]};
#pragma unroll
        for (int ai = 0; ai < 2; ++ai)
#pragma unroll
            for (int m = 0; m < 4; ++m) { unsigned char* rowp = H + (size_t)(row0 + ai * HALF + m * 16) * ldc + col0;
                u32x2 w;
#pragma unroll
                for (int n = 0; n < 2; ++n) { const f32x4 ag = acc[ai][0][m][n], au = acc[ai][1][m][n]; const f32x4 t = ag * c1v; f32x4 e, r;
#pragma unroll
                    for (int i = 0; i < 4; ++i) e[i] = __builtin_amdgcn_exp2f(t[i]);
                    const f32x4 d = e * ic2v + ic2v;
#pragma unroll
                    for (int i = 0; i < 4; ++i) r[i] = __builtin_amdgcn_rcpf(d[i]);
                    const f32x4 hv = (ag * au) * r;
                    const unsigned pk = pk4_fp8(hv[0], hv[1], hv[2], hv[3]); if (n == 0) w.x = pk; else w.y = pk; }
                *(u32x2*)rowp = w; }
    }
};

template <bool FP8, class Epi>
__device__ __forceinline__ void gemm_phase(LAS unsigned char* lds, const Gemm g, const Order& S, const Epi& E, const int tid) {
    const int wid = __builtin_amdgcn_readfirstlane(tid >> 6), lane = tid & 63, wr = wid >> 2, wc = wid & 3, fr = lane & 15, fq = lane >> 4;
    const int nt = g.nt;
    auto stage_off = [&](bool isB) -> unsigned { const int t_ = tid; int R, C; stage_rc(t_ * 16, R, C); const int Rb = (isB && Epi::PERM) ? ((R & ~31) + perm32(R & 31)) : R;
        return (unsigned)(Rb * (isB ? g.ldb : g.lda) + C) * 2u; };
    const unsigned voffA0 = stage_off(false), voffB0 = stage_off(true);
    const size_t pstepA = (size_t)64 * g.lda * 2, pstepB = (size_t)64 * g.ldb * 2;
    const size_t kstep = (size_t)(BK * 2);
    const size_t hstepA = (size_t)HALF * g.lda * 2, hstepB = (size_t)HALF * g.ldb * 2;
    const size_t tstepA = 2 * hstepA, tstepB = 2 * hstepB;
    const unsigned ldsw = (unsigned)wid * 1024u; const unsigned ldsb = (unsigned)(size_t)lds + ldsw;
    const int aoff = lds_byte(wr * 64 + fr, fq * 8), boff = lds_byte(wc * 32 + fr, fq * 8);
#define PG8_SA(b, h) (((b) * 2 + (h)) * HTB)
#define PG8_SB(b, h) ((4 + (b) * 2 + (h)) * HTB)
#define voffA false
#define voffB true
#define PG8_STAGE(bufoff, gbase, isB) do { const unsigned vo_ = (isB) ? voffB0 : voffA0; _Pragma("unroll") for (int _i = 0; _i < 2; ++_i) { \
        const char* gb_ = (const char*)(gbase) + _i * ((isB) ? pstepB : pstepA); const unsigned la_ = ldsb + (unsigned)(bufoff) + (unsigned)(_i * 8192); \
          \
        asm volatile("s_mov_b32 m0, %0\n\ts_nop 0\n\tglobal_load_lds_dwordx4 %1, %2" :: "s"(la_), "v"(vo_), "s"(gb_) : "memory", "m0"); } } while (0)
#define PG8_LDA(dst, b, h) do { _Pragma("unroll") for (int m = 0; m < 4; ++m) _Pragma("unroll") for (int k = 0; k < 2; ++k) dst[m][k] = *(const LAS bf16x8*)(lds + PG8_SA(b, h) + aoff + m * 2048 + k * 1024); } while (0)
#define PG8_LDB(dst, b, h) do { _Pragma("unroll") for (int n = 0; n < 2; ++n) _Pragma("unroll") for (int k = 0; k < 2; ++k) dst[n][k] = *(const LAS bf16x8*)(lds + PG8_SB(b, h) + boff + n * 2048 + k * 1024); } while (0)
#define PG8_CAT8(x) __builtin_shufflevector(__builtin_bit_cast(v4i_t, (x)[0]), __builtin_bit_cast(v4i_t, (x)[1]), 0, 1, 2, 3, 4, 5, 6, 7)
#define PG8_MMA(ai, bj, At, Bt) do { __builtin_amdgcn_s_setprio(1); _Pragma("unroll") for (int m = 0; m < 4; ++m) _Pragma("unroll") for (int n = 0; n < 2; ++n) { \
        if constexpr (FP8) acc[ai][bj][m][n] = __builtin_amdgcn_mfma_scale_f32_16x16x128_f8f6f4(PG8_CAT8(Bt[n]), PG8_CAT8(At[m]), acc[ai][bj][m][n], 0, 0, 0, 0, 0, 0); \
        else { _Pragma("unroll") for (int k = 0; k < 2; ++k) acc[ai][bj][m][n] = __builtin_amdgcn_mfma_f32_16x16x32_bf16(Bt[n][k], At[m][k], acc[ai][bj][m][n], 0, 0, 0); } } \
        __builtin_amdgcn_s_setprio(0); } while (0)
#define PG8_WAIT_V(n) asm volatile("s_waitcnt vmcnt(" #n ")" ::: "memory")
#define PG8_WAIT_L(n) asm volatile("s_waitcnt lgkmcnt(" #n ")" ::: "memory")
#define PG8_BAR __builtin_amdgcn_s_barrier()
#define PG8_SCHED __builtin_amdgcn_sched_barrier(0)
    Unit cur, nxt; int ui = 0;
    if (!S.next(0, cur, nt)) return;
    f32x4 acc[2][2][4][2];
#pragma unroll
    for (int a = 0; a < 2; ++a)
#pragma unroll
        for (int b = 0; b < 2; ++b)
#pragma unroll
            for (int m = 0; m < 4; ++m)
#pragma unroll
                for (int n = 0; n < 2; ++n) acc[a][b][m][n] = (f32x4){0.f, 0.f, 0.f, 0.f};
    bf16x8 At[4][2], B0[2][2], B1[2][2];
    const char* cA = (const char*)g.A + (size_t)cur.pm * tstepA + (size_t)cur.k0 * kstep;
    const char* cB = (const char*)g.Bt + (size_t)cur.pn * tstepB + (size_t)cur.k0 * kstep;
    PG8_STAGE(PG8_SB(0, 0), cB, voffB); PG8_STAGE(PG8_SB(0, 1), cB + hstepB, voffB); PG8_STAGE(PG8_SA(0, 0), cA, voffA); PG8_STAGE(PG8_SA(0, 1), cA + hstepA, voffA);
    if (wr == 1) PG8_BAR;
    PG8_WAIT_V(2); PG8_BAR;
    PG8_STAGE(PG8_SB(1, 0), cB + kstep, voffB); PG8_STAGE(PG8_SA(1, 0), cA + kstep, voffA); PG8_STAGE(PG8_SB(1, 1), cB + hstepB + kstep, voffB);
    PG8_WAIT_V(6); PG8_BAR;
    for (;;) {
        const bool has_next = S.next(ui + 1, nxt, nt);
        const char* nA = has_next ? (const char*)g.A + (size_t)nxt.pm * tstepA + (size_t)nxt.k0 * kstep : cA;
        const char* nB = has_next ? (const char*)g.Bt + (size_t)nxt.pn * tstepB + (size_t)nxt.k0 * kstep : cB;
        const int cnt = cur.nt;
        for (int t = 0; t < cnt; t += 2) {
            const bool last = (t == cnt - 2);
            const char* a1 = cA + (size_t)(t + 1) * kstep;
            const char* a2 = last ? nA : cA + (size_t)(t + 2) * kstep; const char* b2 = last ? nB : cB + (size_t)(t + 2) * kstep;
            const char* a3 = a2 + kstep; const char* b3 = b2 + kstep;
            PG8_LDB(B0, 0, 0); PG8_LDB(B1, 0, 1); PG8_SCHED; PG8_LDA(At, 0, 0); PG8_STAGE(PG8_SA(1, 1), a1 + hstepA, voffA);
            PG8_WAIT_V(8); PG8_WAIT_L(0); PG8_BAR; PG8_MMA(0, 0, At, B0); PG8_MMA(0, 1, At, B1); PG8_BAR; PG8_SCHED;
            PG8_LDA(At, 0, 1); PG8_STAGE(PG8_SB(0, 0), b2, voffB); PG8_STAGE(PG8_SB(0, 1), b2 + hstepB, voffB); PG8_STAGE(PG8_SA(0, 0), a2, voffA);
            PG8_WAIT_V(8); PG8_WAIT_L(0); PG8_BAR; PG8_MMA(1, 0, At, B0); PG8_MMA(1, 1, At, B1); PG8_BAR; PG8_SCHED;
            PG8_LDB(B0, 1, 0); PG8_LDB(B1, 1, 1); PG8_SCHED; PG8_LDA(At, 1, 0); PG8_STAGE(PG8_SA(0, 1), a2 + hstepA, voffA);
            PG8_WAIT_V(8); PG8_WAIT_L(0); PG8_BAR; PG8_MMA(0, 0, At, B0); PG8_MMA(0, 1, At, B1); PG8_BAR; PG8_SCHED;
            PG8_LDA(At, 1, 1); PG8_STAGE(PG8_SB(1, 0), b3, voffB); PG8_STAGE(PG8_SB(1, 1), b3 + hstepB, voffB); PG8_STAGE(PG8_SA(1, 0), a3, voffA);
            PG8_WAIT_V(8); PG8_WAIT_L(0); PG8_BAR; PG8_MMA(1, 0, At, B0); PG8_MMA(1, 1, At, B1); PG8_BAR; PG8_SCHED;
        }
        if (wr == 0) PG8_BAR;
        { const int l2 = launder_v(tid) & 63; E(acc, cur, wr, wc, l2 & 15, l2 >> 4); }
        if (!has_next) break;
#pragma unroll
        for (int a = 0; a < 2; ++a)
#pragma unroll
            for (int b = 0; b < 2; ++b)
#pragma unroll
                for (int m = 0; m < 4; ++m)
#pragma unroll
                    for (int n = 0; n < 2; ++n) { f32x2 lo_, hi_; asm volatile("v_pk_mov_b32 %0, 0, 0" : "=v"(lo_)); asm volatile("v_pk_mov_b32 %0, 0, 0" : "=v"(hi_));
                        acc[a][b][m][n] = (f32x4){lo_[0], lo_[1], hi_[0], hi_[1]}; }
        cur = nxt; cA = nA; cB = nB; ++ui;
        if (wr == 1) PG8_BAR;
    }
    PG8_WAIT_V(0);
    PG8_BAR;
#undef PG8_SA
#undef PG8_SB
#undef PG8_STAGE
#undef voffA
#undef voffB
#undef PG8_LDA
#undef PG8_LDB
#undef PG8_MMA
#undef PG8_CAT8
#undef PG8_WAIT_V
#undef PG8_WAIT_L
#undef PG8_BAR
#undef PG8_SCHED
}
}

namespace att {
constexpr int D = 128, NW = 8, QBLK = 32, KVBLK = 64;
constexpr float SCALE = 0.088388347648318440f;
constexpr float THR = 8.f;
constexpr int LDQ = 1024, LDK = 256, LDO = 2048;
constexpr size_t SHM_V = KVBLK * D * 2, SHM_K = KVBLK * D * 2, SHM_ATTN = 2 * SHM_V + 2 * SHM_K + NW * 64 * 4;
#define KSWZ(row, colB) ((row) * 256 + ((colB) ^ (((row) & 7) << 4)))
#define SBAR() __builtin_amdgcn_sched_barrier(0)
__device__ __forceinline__ int crow(int r, int hi) { return (r & 3) + 8 * (r >> 2) + 4 * hi; }
__device__ __forceinline__ unsigned cvtpk(float lo, float hi) { unsigned r; asm volatile("v_cvt_pk_bf16_f32 %0, %1, %2" : "=v"(r) : "v"(lo), "v"(hi)); return r; }
__device__ __forceinline__ void partialSM(f32x16& p0, f32x16& p1, float& m_reg, float& mn, float& alpha) {
  constexpr float C = SCALE * 1.4426950408889634f;
  float pmax = p0[0]; for (int r = 1; r < 16; ++r) pmax = fmaxf(pmax, p0[r]); for (int r = 0; r < 16; ++r) pmax = fmaxf(pmax, p1[r]);
  { auto rr = __builtin_amdgcn_permlane32_swap(__float_as_uint(pmax), __float_as_uint(pmax), false, false);
    pmax = fmaxf(__uint_as_float(rr[0]), __uint_as_float(rr[1])); }
  if (__builtin_expect(__all(pmax - m_reg <= THR / SCALE), 1)) { mn = m_reg; alpha = 1.f; }
  else { mn = fmaxf(m_reg, pmax); alpha = __builtin_amdgcn_exp2f((m_reg - mn) * C); m_reg = mn; }
  float mnC = -mn * C;
  for (int r = 0; r < 16; ++r) p0[r] = fmaf(p0[r], C, mnC); for (int r = 0; r < 16; ++r) p1[r] = fmaf(p1[r], C, mnC);
  for (int r = 0; r < 16; ++r) p0[r] = __builtin_amdgcn_exp2f(p0[r]);
}
__device__ __forceinline__ void finishSM(f32x16& p0, f32x16& p1, float alpha, float& l_reg, bf16x8& pa0, bf16x8& pa1, bf16x8& pa2, bf16x8& pa3) {
  for (int r = 0; r < 16; ++r) p1[r] = __builtin_amdgcn_exp2f(p1[r]);
  float ps = 0; for (int r = 0; r < 16; ++r) ps += p0[r]; for (int r = 0; r < 16; ++r) ps += p1[r];
  { auto rr = __builtin_amdgcn_permlane32_swap(__float_as_uint(ps), __float_as_uint(ps), false, false);
    ps = __uint_as_float(rr[0]) + __uint_as_float(rr[1]); }
  l_reg = l_reg * alpha + ps;
#define PK4(P, BASE, OUT) do { unsigned a0 = cvtpk(P[BASE + 0], P[BASE + 1]), a1 = cvtpk(P[BASE + 2], P[BASE + 3]);   \
    unsigned b0 = cvtpk(P[BASE + 4], P[BASE + 5]), b1 = cvtpk(P[BASE + 6], P[BASE + 7]);                              \
    auto r0 = __builtin_amdgcn_permlane32_swap(a0, b0, false, false); auto r1 = __builtin_amdgcn_permlane32_swap(a1, b1, false, false); \
    u32x4 w = {r0[0], r1[0], r0[1], r1[1]}; OUT = *reinterpret_cast<bf16x8*>(&w); } while (0)
  PK4(p0, 0, pa0); PK4(p0, 8, pa1); PK4(p1, 0, pa2); PK4(p1, 8, pa3);
#undef PK4
}
__device__ __forceinline__ void qkt(f32x16& p0, f32x16& p1, const bf16_t* Ks, const bf16x8* qr, int r32, int hi) {
  p0 = f32x16{}; p1 = f32x16{};
  for (int d0 = 0; d0 < 8; ++d0) { int cb = (d0 * 16 + hi * 8) * 2;
    bf16x8 b0 = *reinterpret_cast<const bf16x8*>((const char*)Ks + KSWZ(r32, cb));
    bf16x8 b1 = *reinterpret_cast<const bf16x8*>((const char*)Ks + KSWZ(32 + r32, cb));
    p0 = __builtin_amdgcn_mfma_f32_32x32x16_bf16(b0, qr[d0], p0, 0, 0, 0);
    p1 = __builtin_amdgcn_mfma_f32_32x32x16_bf16(b1, qr[d0], p1, 0, 0, 0); }
}
__device__ __forceinline__ int v_st(int k, int c) { const int kk = (k & ~0xC) | ((k & 4) << 1) | ((k & 8) >> 1); return ((kk >> 3) * 4 + (c >> 5)) * 512 + ((kk & 7) * 32 + (c & 31)) * 2; }
__device__ __forceinline__ int v_rd_base(int lane) { return ((lane & 3) << 3) | (((lane >> 2) & 3) << 6) | (((lane >> 4) & 1) << 5) | (((lane >> 5) & 1) << 8); }
constexpr int v_rd_off(int d0, int ks, int half) { return d0 * 512 + ks * 4096 + half * 2048; }
template <int OFF> __device__ __forceinline__ s16x4 tr_read(int vb) {
  s16x4 r; asm volatile("ds_read_b64_tr_b16 %0, %1 offset:%2" : "=&v"(r) : "v"(vb), "i"(OFF) : "memory"); return r;
}
template <int D0> __device__ __forceinline__ void pv_one(f32x16& od, int vb, bf16x8 pa0, bf16x8 pa1, bf16x8 pa2, bf16x8 pa3) {
  const s16x4 l0 = tr_read<v_rd_off(D0, 0, 0)>(vb), h0 = tr_read<v_rd_off(D0, 0, 1)>(vb), l1 = tr_read<v_rd_off(D0, 1, 0)>(vb), h1 = tr_read<v_rd_off(D0, 1, 1)>(vb);
  const s16x4 l2 = tr_read<v_rd_off(D0, 2, 0)>(vb), h2 = tr_read<v_rd_off(D0, 2, 1)>(vb), l3 = tr_read<v_rd_off(D0, 3, 0)>(vb), h3 = tr_read<v_rd_off(D0, 3, 1)>(vb);
  asm volatile("s_waitcnt lgkmcnt(0)" ::: "memory"); SBAR();
#define PK(L, H) (bf16x8){L[0], L[1], L[2], L[3], H[0], H[1], H[2], H[3]}
  od = __builtin_amdgcn_mfma_f32_32x32x16_bf16(pa0, PK(l0, h0), od, 0, 0, 0);
  od = __builtin_amdgcn_mfma_f32_32x32x16_bf16(pa1, PK(l1, h1), od, 0, 0, 0);
  od = __builtin_amdgcn_mfma_f32_32x32x16_bf16(pa2, PK(l2, h2), od, 0, 0, 0);
  od = __builtin_amdgcn_mfma_f32_32x32x16_bf16(pa3, PK(l3, h3), od, 0, 0, 0);
#undef PK
}
__device__ __forceinline__ void pv_d0(f32x16* o, int vb, bf16x8 pa0, bf16x8 pa1, bf16x8 pa2, bf16x8 pa3) {
  pv_one<0>(o[0], vb, pa0, pa1, pa2, pa3); pv_one<1>(o[1], vb, pa0, pa1, pa2, pa3); pv_one<2>(o[2], vb, pa0, pa1, pa2, pa3); pv_one<3>(o[3], vb, pa0, pa1, pa2, pa3);
}
__device__ __forceinline__ void attn_unit(const bf16_t* __restrict__ Qb, const bf16_t* __restrict__ Kh, const bf16_t* __restrict__ Vh, unsigned char* __restrict__ Ob, int seq, char* lds, const int tid) {
  const int wid = tid >> 6, lane = tid & 63, r32 = lane & 31, hi = lane >> 5;
  bf16_t* V_lds = (bf16_t*)lds; bf16_t* K_lds = (bf16_t*)(lds + 2 * SHM_V);
  float* ws = (float*)(lds + 2 * SHM_V + 2 * SHM_K) + wid * 64; float* li_l = ws; float* al_l = ws + 32;
  float m_reg = -1e30f, l_reg = 0; f32x16 o[4] = {}; bf16x8 qr[8];
  const bf16_t* Qw = Qb + (long)(wid * QBLK + r32) * LDQ + hi * 8;
#pragma unroll
  for (int d0 = 0; d0 < 8; ++d0) qr[d0] = *reinterpret_cast<const bf16x8*>(Qw + d0 * 16);
  const int sr = tid >> 4, sc = (tid & 15) * 8, vst0 = v_st(sr, sc), vst1 = v_st(32 + sr, sc);
  const int vb0 = (int)(uintptr_t)V_lds + v_rd_base(lane);
  struct { bf16x8 vs0, vs1, ks0, ks1; } sr_[2];
#define SLOAD(i, k0) do { sr_[i].vs0 = *reinterpret_cast<const bf16x8*>(&Vh[(long)((k0) + sr) * LDK + sc]); sr_[i].vs1 = *reinterpret_cast<const bf16x8*>(&Vh[(long)((k0) + 32 + sr) * LDK + sc]); \
    sr_[i].ks0 = *reinterpret_cast<const bf16x8*>(&Kh[(long)((k0) + sr) * LDK + sc]); sr_[i].ks1 = *reinterpret_cast<const bf16x8*>(&Kh[(long)((k0) + 32 + sr) * LDK + sc]); } while (0)
#define SWRITE(b, i) do { *(bf16x8*)((char*)V_lds + (b) * SHM_V + vst0) = sr_[i].vs0;          \
    *(bf16x8*)((char*)V_lds + (b) * SHM_V + vst1) = sr_[i].vs1; int kc = sc * 2;               \
    *(bf16x8*)((char*)K_lds + (b) * SHM_K + KSWZ(sr, kc)) = sr_[i].ks0;                       \
    *(bf16x8*)((char*)K_lds + (b) * SHM_K + KSWZ(32 + sr, kc)) = sr_[i].ks1; } while (0)
#define SWAIT() asm volatile("s_waitcnt vmcnt(4)" ::: "memory")
#define RESC(a) do { if (__any((a) < 1.f)) { if (hi == 0) al_l[r32] = (a); asm volatile("s_waitcnt lgkmcnt(0)" ::: "memory"); \
    for (int d = 0; d < 4; ++d) for (int r = 0; r < 16; ++r) o[d][r] *= al_l[crow(r, hi)]; } } while (0)
  f32x16 pA0, pA1, pB0, pB1; float mnA, mnB, alA, alB; bf16x8 pa0, pa1, pa2, pa3; const int NT = seq / KVBLK;
  constexpr int SE = 0, SO = 1;
  SLOAD(SE, 0); asm volatile("s_waitcnt vmcnt(0)" ::: "memory"); SWRITE(0, SE); __syncthreads();
  qkt(pA0, pA1, K_lds, qr, r32, hi); partialSM(pA0, pA1, m_reg, mnA, alA);
  SLOAD(SO, KVBLK); if (2 < NT) SLOAD(SE, 2 * KVBLK);
  SWAIT(); SWRITE(1, SO); __syncthreads();
  for (int j = 1; j + 1 < NT; j += 2) {
    SBAR(); qkt(pB0, pB1, (bf16_t*)((char*)K_lds + SHM_K), qr, r32, hi);
    finishSM(pA0, pA1, alA, l_reg, pa0, pa1, pa2, pa3); SBAR();
    SLOAD(SO, (j + 2) * KVBLK); SBAR();
    pv_d0(o, vb0, pa0, pa1, pa2, pa3); partialSM(pB0, pB1, m_reg, mnB, alB);
    __syncthreads(); SWAIT(); SWRITE(0, SE);
    RESC(alB); __syncthreads();
    SBAR(); qkt(pA0, pA1, K_lds, qr, r32, hi);
    finishSM(pB0, pB1, alB, l_reg, pa0, pa1, pa2, pa3); SBAR();
    if (j + 3 < NT) SLOAD(SE, (j + 3) * KVBLK); SBAR();
    pv_d0(o, vb0 + (int)SHM_V, pa0, pa1, pa2, pa3); partialSM(pA0, pA1, m_reg, mnA, alA);
    __syncthreads(); SWAIT(); SWRITE(1, SO);
    RESC(alA); __syncthreads();
  }
  SBAR(); qkt(pB0, pB1, (bf16_t*)((char*)K_lds + SHM_K), qr, r32, hi);
  finishSM(pA0, pA1, alA, l_reg, pa0, pa1, pa2, pa3); SBAR();
  pv_d0(o, vb0, pa0, pa1, pa2, pa3); partialSM(pB0, pB1, m_reg, mnB, alB);
  __syncthreads(); RESC(alB);
  finishSM(pB0, pB1, alB, l_reg, pa0, pa1, pa2, pa3); SBAR();
  pv_d0(o, vb0 + (int)SHM_V, pa0, pa1, pa2, pa3);
  if (hi == 0) li_l[r32] = l_reg; asm volatile("s_waitcnt lgkmcnt(0)" ::: "memory");
  float rli[16];
#pragma unroll
  for (int r = 0; r < 16; ++r) rli[r] = __builtin_amdgcn_rcpf(li_l[crow(r, hi)]);
  { int le = lane; asm volatile("" : "+v"(le));
    const int r32e = le & 31, hie = le >> 5;
    unsigned char* ot = (unsigned char*)lds + 69632 + wid * 4096;
#pragma unroll
    for (int r = 0; r < 16; ++r) { const int orow = crow(r, hie);
      const float rl4 = rli[r] * S8_MA; const unsigned w = pk4_fp8(o[0][r] * rl4, o[1][r] * rl4, o[2][r] * rl4, o[3][r] * rl4);
      for (int d0 = 0; d0 < 4; ++d0) ot[orow * 128 + d0 * 32 + r32e] = (unsigned char)(w >> (8 * d0)); }
    asm volatile("s_waitcnt lgkmcnt(0)" ::: "memory");
    unsigned char* Ow = Ob + (long)(wid * QBLK + (le >> 3)) * LDO + (le & 7) * 16;
#pragma unroll
    for (int k = 0; k < 4; ++k) *(u32x4*)(Ow + (long)(8 * k) * LDO) = *(const u32x4*)(ot + k * 1024 + le * 16); }
#undef SLOAD
#undef SWRITE
#undef SWAIT
#undef RESC
}
}

#define XB_TMO      128
#define XB_XCNT(j)  (256  + 64 * (j))
#define XB_XSUB(j)  (1280 + 64 * (j))
#define XB_XGEN(j)  (2304 + 64 * (j))
#define XB_TOP      3328
#define XB_TOPGEN   3392
#define XCD_BAR_WORDS 3456
#define XB_SPIN_CAP (1u << 22)
__device__ __forceinline__ unsigned xb_ld(unsigned* p)              { return __hip_atomic_load(p, __ATOMIC_RELAXED, __HIP_MEMORY_SCOPE_AGENT); }
__device__ __forceinline__ unsigned xb_add(unsigned* p, unsigned v) { return __hip_atomic_fetch_add(p, v, __ATOMIC_RELAXED, __HIP_MEMORY_SCOPE_AGENT); }
__device__ __forceinline__ unsigned xb_xcc_id() { return (unsigned)__builtin_amdgcn_s_getreg((3 << 11) | 20) & 0xFu; }
#define XB_SPIN(cond, bar) do { unsigned _sp = 0; while (cond) { __builtin_amdgcn_s_sleep(1); \
    if ((++_sp & 255u) == 0u) { if (xb_ld(&(bar)[XB_TMO])) break; if (_sp > XB_SPIN_CAP) { atomicAdd(&(bar)[XB_TMO], 1u); break; } } } } while (0)
struct XcdBarrier { unsigned* bar; unsigned x; volatile LAS unsigned* st; bool lead; };
__device__ __forceinline__ XcdBarrier xcd_barrier_post(unsigned* bar, volatile LAS unsigned* st, bool lead) {
    XcdBarrier b; b.bar = bar; b.x = xb_xcc_id(); b.st = st; b.lead = lead;
    if (lead && hw_lane() == 0) (void)xb_add(&bar[XB_XCNT(b.x)], 1u);
    return b;
}
__device__ __forceinline__ void xcd_barrier_complete(unsigned* bar, unsigned x, unsigned& nloc, unsigned& nx) {
    const unsigned G = gridDim.x * gridDim.y * gridDim.z;
    unsigned sum, cnt, mine, sp = 0u;
    for (;;) {
        sum = 0u; cnt = 0u; mine = 0u;
#pragma unroll
        for (unsigned j = 0; j < 16; ++j) { const unsigned c = xb_ld(&bar[XB_XCNT(j)]); sum += c; cnt += (c > 0u) ? 1u : 0u; mine = (j == x) ? c : mine; }
        if (sum == G) break;
        __builtin_amdgcn_s_sleep(1);
        if ((++sp & 255u) == 0u) { if (xb_ld(&bar[XB_TMO])) break; if (sp > XB_SPIN_CAP) { atomicAdd(&bar[XB_TMO], 1u); break; } }
    }
    nloc = mine > 0u ? mine : 1u; nx = cnt > 0u ? cnt : 1u;
}
__device__ __forceinline__ void xcd_barrier(const XcdBarrier& b) {
    asm volatile("s_waitcnt vmcnt(0)" ::: "memory");
    __syncthreads();
    if (b.lead && hw_lane() == 0) {
        unsigned* bar = b.bar;
        __builtin_amdgcn_s_waitcnt(0);
        unsigned nloc = b.st[0], nx = b.st[1];
        if (nloc == 0u) { xcd_barrier_complete(bar, b.x, nloc, nx); b.st[0] = nloc; b.st[1] = nx; }
        const unsigned old = xb_add(&bar[XB_XSUB(b.x)], 1u);
        const unsigned gen = old / nloc;
        if (old + 1u == (gen + 1u) * nloc) {
            __builtin_amdgcn_fence(__ATOMIC_RELEASE, "agent");
            asm volatile("s_waitcnt vmcnt(0)" ::: "memory");
            const unsigned og = xb_add(&bar[XB_TOP], 1u);
            const unsigned tg = og / nx;
            if (og + 1u == (tg + 1u) * nx) xb_add(&bar[XB_TOPGEN], 1u);
            else XB_SPIN(xb_ld(&bar[XB_TOPGEN]) == tg, bar);
            __builtin_amdgcn_fence(__ATOMIC_ACQUIRE, "agent");
            xb_add(&bar[XB_XGEN(b.x)], 1u);
            asm volatile("s_waitcnt vmcnt(0)" ::: "memory");
        } else {
            XB_SPIN(xb_ld(&bar[XB_XGEN(b.x)]) == gen, bar);
            __builtin_amdgcn_fence(__ATOMIC_ACQUIRE, "agent");
            asm volatile("s_waitcnt vmcnt(0)" ::: "memory");
        }
    }
    __syncthreads();
}

struct Args { const float* in[N_IN]; float* out; unsigned char* ws; int ph_lo, ph_hi; };
struct Frame {
    LAS unsigned char* lds;
    int tid, lane, wave, G, vcu, gw, ngw, bx;
    float* out; unsigned char* ws;
};
__device__ __forceinline__ const float* inp(int i) {
    const __attribute__((address_space(4))) char* ka = (const __attribute__((address_space(4))) char*)__builtin_amdgcn_kernarg_segment_ptr();
    asm volatile("" : "+s"(ka));
    return (const float*)(const GAS float*)*(const float* const __attribute__((address_space(4)))*)(ka + 8 * i);
}
#define FRESH(P) Frame P; { P.lds = F.lds; P.out = F.out; size_t z_ = 0; asm volatile("" : "+s"(z_)); P.ws = F.ws + z_; P.tid = launder_v(F.wave * 64 + hw_lane());     P.lane = P.tid & 63; \
    P.wave = __builtin_amdgcn_readfirstlane(P.tid >> 6); P.G = launder_s((int)gridDim.x); const int bx_ = launder_s((int)blockIdx.x); P.bx = bx_; \
    P.vcu = (P.G % 8 == 0) ? (bx_ % 8) * (P.G / 8) + bx_ / 8 : bx_; P.gw = P.vcu * 8 + P.wave; P.ngw = P.G * 8; }
#define WSP(T, off) ((T*)(F.ws + (off)))
#define F_MOD  WSP(float, WS_MOD)
#define F_ROPE WSP(float, WS_ROPE)
#define F_GDEC WSP(float, WS_GDEC)
#define F_MODP WSP(float, WS_MODP)
#define F_WIN8 WSP(unsigned char, WS_WIN)
#define F_WOUT8 WSP(unsigned char, WS_WOUT)
#define F_WMI16 WSP(bf16_t, WS_WMI)
#define F_WMI8 WSP(unsigned char, WS_WMI + WMI8_OFF)
#define F_WMO8 WSP(unsigned char, WS_WMO)
#define F_U    WSP(bf16_t, WS_U)
#define F_H8   WSP(unsigned char, WS_H)
#define F_U8   WSP(unsigned char, WS_U8)
#define F_Y8   WSP(unsigned char, WS_Y)
#define F_PROJ WSP(bf16_t, WS_PROJ)
#define F_QB   WSP(bf16_t, WS_QB)
#define F_KB   WSP(bf16_t, WS_KB)
#define F_VB   WSP(bf16_t, WS_VB)
#define F_LA   WSP(float, WS_LA)
#define F_MA8  WSP(unsigned char, WS_MA)
#define F_RKV  WSP(float, WS_RKV)
#define F_GKV  WSP(float, WS_GKV)
#define F_RSP  WSP(bf16_t, WS_RSP)
#define F_GSP  WSP(bf16_t, WS_GSP)
#define F_GA   WSP(float, WS_GA)
#define F_X    WSP(bf16_t, WS_X)
__device__ __forceinline__ int row_vec(int row) { return row < M_CTX ? 0 : 1 + ((row - M_CTX) >> 12); }

typedef short v4i16_t __attribute__((ext_vector_type(4)));
__device__ __forceinline__ bf16x8 frag_row(const LAS bf16_t* T, int LD, int idx0, int k0, int lane) {
    return *(const LAS bf16x8*)(T + (idx0 + (lane & 15)) * LD + k0 + 8 * (lane >> 4));
}
__device__ __forceinline__ bf16x8 frag_tr(const LAS bf16_t* T, int LD, int k0, int idx0, int lane) {
    const LAS bf16_t* p = T + (k0 + 8 * (lane >> 4) + ((lane >> 2) & 3)) * LD + idx0 + 4 * (lane & 3);
    const v4i16_t lo = __builtin_amdgcn_ds_read_tr16_b64_v4i16((LAS v4i16_t*)p);
    const v4i16_t hi = __builtin_amdgcn_ds_read_tr16_b64_v4i16((LAS v4i16_t*)(p + 4 * LD));
    return (bf16x8){lo[0], lo[1], lo[2], lo[3], hi[0], hi[1], hi[2], hi[3]};
}
template <int TM, int TN, bool RTR, bool CTR>
__device__ __forceinline__ void mmb(f32x4 (&acc)[TM][TN], const LAS bf16_t* R, int ldr, int r0, const LAS bf16_t* X, int ldx, int c0, int K, int lane) {
#pragma unroll 2
    for (int k0 = 0; k0 < K; k0 += 32) {
        bf16x8 fr[TM], fc[TN];
#pragma unroll
        for (int tm = 0; tm < TM; ++tm) fr[tm] = RTR ? frag_tr(R, ldr, k0, r0 + 16 * tm, lane) : frag_row(R, ldr, r0 + 16 * tm, k0, lane);
#pragma unroll
        for (int tn = 0; tn < TN; ++tn) fc[tn] = CTR ? frag_tr(X, ldx, k0, c0 + 16 * tn, lane) : frag_row(X, ldx, c0 + 16 * tn, k0, lane);
#pragma unroll
        for (int tm = 0; tm < TM; ++tm)
#pragma unroll
            for (int tn = 0; tn < TN; ++tn) acc[tm][tn] = __builtin_amdgcn_mfma_f32_16x16x32_bf16(fc[tn], fr[tm], acc[tm][tn], 0, 0, 0);
    }
}
template <int TM, int TN> __device__ __forceinline__ void zero_acc(f32x4 (&acc)[TM][TN]) {
#pragma unroll
    for (int tm = 0; tm < TM; ++tm)
#pragma unroll
        for (int tn = 0; tn < TN; ++tn) acc[tm][tn] = (f32x4){0.f, 0.f, 0.f, 0.f};
}
template <int ROWS, int COLS>
__device__ __forceinline__ void stage_f32(LAS float* dst, int LD, const float* src, size_t ld_src, int tid) {
    constexpr int C4 = COLS / 4, N4 = ROWS * C4, NB = N4 / 512;
    static_assert(N4 % 512 == 0 && NB <= 8, "stage_f32 geometry");
    f32x4 v[NB];
#pragma unroll
    for (int b = 0; b < NB; ++b) { const int idx = tid + 512 * b, r = idx / C4, c = idx - r * C4; v[b] = *(const f32x4*)(src + (size_t)r * ld_src + 4 * c); }
#pragma unroll
    for (int b = 0; b < NB; ++b) { const int idx = tid + 512 * b, r = idx / C4, c = idx - r * C4;
        LAS f32x2* d = (LAS f32x2*)(dst + r * LD + 4 * c); d[0] = (f32x2){v[b][0], v[b][1]}; d[1] = (f32x2){v[b][2], v[b][3]}; }
}
template <int ROWS, int COLS>
__device__ __forceinline__ void stage_bf16(LAS bf16_t* dst, int LD, const bf16_t* src, size_t ld_src, int tid) {
    constexpr int C8 = COLS / 8, N8 = ROWS * C8, NB = N8 / 512;
    static_assert(N8 % 512 == 0 && NB <= 8, "stage_bf16 geometry");
    u32x4 v[NB];
#pragma unroll
    for (int b = 0; b < NB; ++b) { const int idx = tid + 512 * b, r = idx / C8, c = idx - r * C8; v[b] = *(const u32x4*)(src + (size_t)r * ld_src + 8 * c); }
#pragma unroll
    for (int b = 0; b < NB; ++b) { const int idx = tid + 512 * b, r = idx / C8, c = idx - r * C8; *(LAS u32x4*)(dst + r * LD + 8 * c) = v[b]; }
}
__device__ __forceinline__ void rope8(float (&x)[8], int c8, int t, const float* ropeT) {
    const int pos = (c8 >= 8) ? (t & 63) : (t >> 6), f0 = (4 * c8) & 31;
    const f32x4 cs = *(const f32x4*)(ropeT + pos * 32 + f0), sn = *(const f32x4*)(ropeT + 2048 + pos * 32 + f0);
#pragma unroll
    for (int p = 0; p < 4; ++p) { const float a = x[2 * p], b = x[2 * p + 1]; x[2 * p] = a * cs[p] - b * sn[p]; x[2 * p + 1] = a * sn[p] + b * cs[p]; }
}

struct TItem { const float* src; unsigned char* dst; int N, K; float sc; };
__device__ __forceinline__ void titem_load(const TItem& d, f32x4 (&v)[8], int lane) {
#pragma unroll
    for (int i = 0; i < 8; ++i) v[i] = __builtin_nontemporal_load((const f32x4*)(d.src + (size_t)(8 * i + (lane >> 3)) * d.N + 4 * (lane & 7)));
}
__device__ __forceinline__ void titem_finish(const TItem& d, const f32x4 (&v)[8], LAS float* scr, int lane) {
#pragma unroll
    for (int i = 0; i < 8; ++i) { LAS float* s = scr + (8 * i + (lane >> 3)) * 33 + 4 * (lane & 7); s[0] = v[i][0]; s[1] = v[i][1]; s[2] = v[i][2]; s[3] = v[i][3]; }
    LDS_WAIT(); asm volatile("" ::: "memory");
    const int c = lane & 7;
    if (d.sc != 0.f) {
#pragma unroll
        for (int j = 0; j < 4; ++j) { const int n = (lane >> 3) + 8 * j; const LAS float* s = scr + (8 * c) * 33 + n; const float sc = d.sc;
            u32x2 o; o.x = pk4_fp8(s[0 * 33] * sc, s[1 * 33] * sc, s[2 * 33] * sc, s[3 * 33] * sc); o.y = pk4_fp8(s[4 * 33] * sc, s[5 * 33] * sc, s[6 * 33] * sc, s[7 * 33] * sc);
            *(u32x2*)(d.dst + (size_t)n * d.K + 8 * c) = o; }
    } else {
#pragma unroll
        for (int j = 0; j < 4; ++j) { const int n = (lane >> 3) + 8 * j; const LAS float* s = scr + (8 * c) * 33 + n;
            u32x4 o; o.x = pk2(s[0 * 33], s[1 * 33]); o.y = pk2(s[2 * 33], s[3 * 33]); o.z = pk2(s[4 * 33], s[5 * 33]); o.w = pk2(s[6 * 33], s[7 * 33]);
            *(u32x4*)(d.dst + ((size_t)n * d.K + 8 * c) * 2) = o; }
    }
    LDS_WAIT(); asm volatile("" ::: "memory");
}
constexpr int CV_OUT = 45056, CV_MI = 67584, CV_MO = 77888, CV_END = 81984;
__device__ __forceinline__ TItem convert_decode(Frame& F, int r) {
    TItem d;
    if (r < CV_OUT) { const int mat = r / 11264, item = r - mat * 11264, kb = item / 352, nb = item - kb * 352, n0 = 32 * nb;
        const int bj = n0 / DFF, j = n0 - bj * DFF, pn = j >> 7, cc = j & 127, drow0 = pn * 256 + bj * 128 + cc;
        d.N = 11264; d.K = 2048; d.sc = S8_WIN; d.src = inp(I_WIN) + (size_t)mat * 2048 * 11264 + (size_t)(64 * kb) * 11264 + n0; d.dst = F_WIN8 + (size_t)mat * 11264 * 2048 + (size_t)drow0 * 2048 + 64 * kb; return d; }
    if (r < CV_MI) { r -= CV_OUT; const int mat = r / 5632, item = r - mat * 5632, kb = item >> 6, nb = item & 63;
        d.N = 2048; d.K = 5632; d.sc = S8_WOUT; d.src = inp(I_WOUT) + (size_t)mat * 5632 * 2048 + (size_t)(64 * kb) * 2048 + 32 * nb; d.dst = F_WOUT8 + (size_t)mat * 2048 * 5632 + (size_t)(32 * nb) * 5632 + 64 * kb; return d; }
    if (r < CV_MO) { r -= CV_MI; const int mat = r / 5152, item = r - mat * 5152, kb = item / 161, nb = item - kb * 161;
        d.N = 5152; d.K = 2048; d.src = inp(I_MWIN) + (size_t)mat * 2048 * 5152 + (size_t)(64 * kb) * 5152 + 32 * nb;
        const int pn = nb >> 3, cc = 32 * (nb & 7); const bool f8 = (MI_F8MASK >> pn) & 1u; const int loc = __builtin_popcount((f8 ? MI_F8MASK : ~MI_F8MASK) & ((1u << pn) - 1u));
        if (f8) { d.sc = S8_WMI; d.dst = F_WMI8 + (size_t)mat * 11 * 256 * 2048 + (size_t)(loc * 256 + cc) * 2048 + 64 * kb; }
        else { d.sc = 0.f; d.dst = (unsigned char*)(F_WMI16 + (size_t)mat * 10 * 256 * 2048 + (size_t)(loc * 256 + cc) * 2048 + 64 * kb); }
        return d; }
    { r -= CV_MO; const int mat = r >> 11, item = r & 2047, kb = item >> 6, nb = item & 63;
        d.N = 2048; d.K = 2048; d.sc = S8_WMO; d.src = inp(I_MWOUT) + (size_t)mat * 2048 * 2048 + (size_t)(64 * kb) * 2048 + 32 * nb; d.dst = F_WMO8 + (size_t)mat * 2048 * 2048 + (size_t)(32 * nb) * 2048 + 64 * kb; return d; }
}
__device__ __forceinline__ void convert_ranges(Frame& F, int a0, int a1, int b0, int b1, int c0, int c1, int worker, int nworkers) {
    LAS float* scr = (LAS float*)(F.lds + F.wave * 8448);
    const int na = a1 - a0, nb = b1 - b0, nc = c1 - c0, n = na + nb + nc;
#define CV_MAP(t) ((t) < na ? a0 + (t) : ((t) < na + nb ? b0 + ((t) - na) : c0 + ((t) - na - nb)))
    for (int t = worker; t < n; t += 2 * nworkers) {
        const int t2 = t + nworkers; const bool two = t2 < n;
        const TItem d1 = convert_decode(F, CV_MAP(t)); const TItem d2 = convert_decode(F, CV_MAP(two ? t2 : t));
        f32x4 v1[8], v2[8];
        titem_load(d1, v1, F.lane); if (two) titem_load(d2, v2, F.lane);
        titem_finish(d1, v1, scr, F.lane); if (two) titem_finish(d2, v2, scr, F.lane);
    }
#undef CV_MAP
}
constexpr int CV_PRO_END = 37856;
__device__ __forceinline__ void phase_prologue_a(Frame& F) {
    constexpr int T_GEMV = 2 * 576;
    LAS float* SC = (LAS float*)(F.lds + 70656);
    for (int i = F.tid; i < 3 * 2048; i += 512) { const int v = i >> 11, k = i & 2047; SC[i] = siluf(v == 0 ? inp(I_CCTX)[k] : inp(I_C)[(v - 1) * 2048 + k]); }
    __syncthreads();
    for (int r = F.gw; r < T_GEMV; r += F.ngw) {
        const int l = r / 576, cg = r - l * 576, cl = F.lane & 7, rg = F.lane >> 3;
        const float* W = inp(I_WMOD) + (size_t)l * 2048 * 18432 + (size_t)rg * 18432 + 32 * cg + 4 * cl;
        const LAS float* c0 = SC + rg;
        f32x4 a0 = {0.f, 0.f, 0.f, 0.f}, a1 = a0, a2 = a0;
#pragma unroll 16
        for (int s = 0; s < 256; ++s) { const f32x4 w = __builtin_nontemporal_load((const f32x4*)(W + (size_t)(8 * s) * 18432));
            const float s0 = c0[8 * s], s1 = c0[2048 + 8 * s], s2 = c0[4096 + 8 * s];
            a0 = a0 + w * s0; a1 = a1 + w * s1; a2 = a2 + w * s2; }
#pragma unroll
        for (int o = 8; o < 64; o <<= 1) {
#pragma unroll
            for (int e = 0; e < 4; ++e) { a0[e] += shflx(a0[e], o); a1[e] += shflx(a1[e], o); a2[e] += shflx(a2[e], o); } }
        if (rg == 0) { const f32x4 bb = *(const f32x4*)(inp(I_BMOD) + l * 18432 + 32 * cg + 4 * cl); float* P = F_MOD + (size_t)(l * 3) * 18432 + 32 * cg + 4 * cl;
            *(f32x4*)(P) = a0 + bb; *(f32x4*)(P + 18432) = a1 + bb; *(f32x4*)(P + 2 * 18432) = a2 + bb; }
    }
    const int nfree = F.ngw - T_GEMV; const int head = nfree > 0 ? (21 * nfree < CV_PRO_END ? 21 * nfree : CV_PRO_END) : 0;
    if (F.gw >= T_GEMV) convert_ranges(F, 0, head, 0, 0, 0, 0, F.gw - T_GEMV, nfree);
    convert_ranges(F, head, CV_PRO_END, 0, 0, 0, 0, F.gw, F.ngw);
    for (int r = F.gw; r < 2 * 28; r += F.ngw) { const int mat = r / 28, t = r - mat * 28; u32x4* p = (u32x4*)(F_WMI16 + (size_t)mat * 10 * 256 * 2048 + (size_t)(9 * 256 + 32 + 8 * t) * 2048);
        for (int i = F.lane; i < 8 * 2048 / 8; i += 64) p[i] = (u32x4){0u, 0u, 0u, 0u}; }
    if (F.gw == F.ngw - 1) {
        for (int e = F.lane; e < 2048; e += 64) { const int pos = e >> 5, f = e & 31;
            const float inv = __builtin_exp2f(-(float)f * (13.287712379549449f / 32.0f));
            const float ang = (float)pos * inv;
            double tt = (double)ang * 0.15915494309189535; tt -= __builtin_rint(tt);
            F_ROPE[e] = __builtin_amdgcn_cosf((float)tt); F_ROPE[2048 + e] = __builtin_amdgcn_sinf((float)tt); }
    }
}
__device__ __forceinline__ const float* x_in_row(Frame& F, int row) { return row < M_CTX ? inp(I_XP) + (size_t)row * DM : inp(I_XS) + (size_t)(row - M_CTX) * DM; }
__device__ __forceinline__ void phase_modulate0(Frame& F) {
    LAS float* V = (LAS float*)F.lds;
    for (int i = F.tid; i < 6 * 512; i += 512) { const int k = i >> 9, c = 4 * (i & 511); const float* p = F_MOD + (size_t)(k % 3) * 18432 + (k / 3) * 2048;
        *(LAS f32x4*)(V + k * 2048 + c) = *(const f32x4*)(p + c); }
    __syncthreads();
    for (int row = F.gw; row < MT; row += F.ngw) {
        const float* x = x_in_row(F, row); const int v = row_vec(row);
        unsigned char* u = F_U8 + (size_t)row * DM;
#pragma unroll
        for (int j = 0; j < 8; ++j) { const int c = 256 * j + 4 * F.lane;
            const f32x4 xv = __builtin_nontemporal_load((const f32x4*)(x + c)), sh = *(const LAS f32x4*)(V + v * 2048 + c), sc = *(const LAS f32x4*)(V + (3 + v) * 2048 + c);
            const f32x4 o = xv * (sc + 1.0f) + sh;
            *(unsigned*)(u + c) = pk4_fp8(o[0], o[1], o[2], o[3]); }
    }
}
__device__ __forceinline__ void phase_post(Frame& F, int l, int s, float wgt, bool first, int nl, int ns) {
    LAS float* V = (LAS float*)F.lds;
    {   const float* lg = inp(I_LNG) + (size_t)(l * 3 + s) * DM; const float* lb = inp(I_LNB) + (size_t)(l * 3 + s) * DM;
        for (int i = F.tid; i < 11 * 512; i += 512) { const int k = i >> 9, c = 4 * (i & 511); const float* p;
            if (k == 0) p = lg; else if (k == 1) p = lb; else if (k < 5) p = F_MOD + (size_t)(l * 3 + (k - 2)) * 18432 + (3 * s + 2) * 2048;
            else if (k < 8) p = F_MOD + (size_t)((nl < DEPTH ? nl : 0) * 3 + (k - 5)) * 18432 + (3 * ns) * 2048; else p = F_MOD + (size_t)((nl < DEPTH ? nl : 0) * 3 + (k - 8)) * 18432 + (3 * ns + 1) * 2048;
            f32x4 val = *(const f32x4*)(p + c);
            if (k >= 2 && k < 5) val = val * (wgt * (1.0f / S8_Y)); else if (k >= 8) val = val + 1.0f;
            *(LAS f32x4*)(V + k * 2048 + c) = val; }
    }
    __syncthreads();
    const bool last = !(nl < DEPTH);
    for (int row0 = F.gw; row0 < MT; row0 += 2 * F.ngw) {
        f32x2 t[2][16]; f32x2 sum[2] = {{0.f, 0.f}, {0.f, 0.f}}; int rows[2] = {row0, row0 + F.ngw}; bool ok[2] = {true, row0 + F.ngw < MT};
#pragma unroll
        for (int q = 0; q < 2; ++q) if (ok[q]) {
            const int lane = launder_v(F.lane);
            const int row = rows[q], v = row_vec(row);
            const float* x = x_in_row(F, row); const bf16_t* xb = F_X + (size_t)row * DM;
            const unsigned char* y0 = F_Y8 + (size_t)row * DM; const unsigned char* y1 = y0 + (size_t)MT * DM;
            const bool two = F.G != 256 || ((row >> 8) % 6) >= 4;
            const LAS float* gate = V + (2 + v) * 2048;
#pragma unroll
            for (int j = 0; j < 4; ++j) { const int c = 512 * j + 8 * lane;
                f32x2 xv[4], ab[4];
                if (first) { const f32x4 x0 = *(const f32x4*)(x + c), x1 = *(const f32x4*)(x + c + 4); xv[0] = (f32x2){x0[0], x0[1]}; xv[1] = (f32x2){x0[2], x0[3]}; xv[2] = (f32x2){x1[0], x1[1]}; xv[3] = (f32x2){x1[2], x1[3]}; }
                else { const u32x4 w = *(const u32x4*)(xb + c);
#pragma unroll
                    for (int k = 0; k < 4; ++k) xv[k] = (f32x2){__uint_as_float(w[k] << 16), __uint_as_float(w[k] & 0xffff0000u)}; }
                { const u32x2 wa = *(const u32x2*)(y0 + c), wb = two ? *(const u32x2*)(y1 + c) : (u32x2){0u, 0u};
                  ab[0] = __builtin_amdgcn_cvt_pk_f32_fp8((int)wa.x, false) + __builtin_amdgcn_cvt_pk_f32_fp8((int)wb.x, false); ab[1] = __builtin_amdgcn_cvt_pk_f32_fp8((int)wa.x, true) + __builtin_amdgcn_cvt_pk_f32_fp8((int)wb.x, true);
                  ab[2] = __builtin_amdgcn_cvt_pk_f32_fp8((int)wa.y, false) + __builtin_amdgcn_cvt_pk_f32_fp8((int)wb.y, false); ab[3] = __builtin_amdgcn_cvt_pk_f32_fp8((int)wa.y, true) + __builtin_amdgcn_cvt_pk_f32_fp8((int)wb.y, true); }
                const f32x4 g0 = *(const LAS f32x4*)(gate + c), g1 = *(const LAS f32x4*)(gate + c + 4);
                const f32x2 g2[4] = {{g0[0], g0[1]}, {g0[2], g0[3]}, {g1[0], g1[1]}, {g1[2], g1[3]}};
#pragma unroll
                for (int k = 0; k < 4; ++k) { const f32x2 tv = xv[k] * ALPHA + g2[k] * ab[k]; t[q][4 * j + k] = tv; sum[q] = sum[q] + tv; } }
        }
#pragma unroll
        for (int q = 0; q < 2; ++q) if (ok[q]) {
            const int lane = launder_v(F.lane);
            const int row = rows[q], v = row_vec(row);
            const float mean = wave_sum(sum[q][0] + sum[q][1]) * (1.0f / DM); f32x2 sq = {0.f, 0.f};
#pragma unroll
            for (int e = 0; e < 16; ++e) { t[q][e] = t[q][e] - mean; sq = sq + t[q][e] * t[q][e]; }
            const float rstd = 1.0f / sqrtf(wave_sum(sq[0] + sq[1]) * (1.0f / DM) + LN_EPS);
            float* xo = F.out + (size_t)row * DM; bf16_t* xbo = F_X + (size_t)row * DM; bf16_t* u = F_U + (size_t)row * DM; unsigned char* u8 = F_U8 + (size_t)row * DM;
            const LAS float* sh_ = V + (5 + v) * 2048; const LAS float* sc_ = V + (8 + v) * 2048;
#pragma unroll
            for (int j = 0; j < 4; ++j) { const int c = 512 * j + 8 * lane;
                f32x2 o[4], m[4];
#pragma unroll
                for (int h = 0; h < 2; ++h) { const f32x4 lg4 = *(const LAS f32x4*)(V + c + 4 * h), lb4 = *(const LAS f32x4*)(V + 2048 + c + 4 * h), sh4 = *(const LAS f32x4*)(sh_ + c + 4 * h), sc4 = *(const LAS f32x4*)(sc_ + c + 4 * h);
#pragma unroll
                    for (int k = 0; k < 2; ++k) { const f32x2 lg2 = {lg4[2 * k], lg4[2 * k + 1]}, lb2 = {lb4[2 * k], lb4[2 * k + 1]}, sh2 = {sh4[2 * k], sh4[2 * k + 1]}, sc2 = {sc4[2 * k], sc4[2 * k + 1]};
                        o[2 * h + k] = (t[q][4 * j + 2 * h + k] * rstd) * lg2 + lb2; m[2 * h + k] = o[2 * h + k] * sc2 + sh2; } }
                if (last) { __builtin_nontemporal_store((f32x4){o[0][0], o[0][1], o[1][0], o[1][1]}, (f32x4*)(xo + c)); __builtin_nontemporal_store((f32x4){o[2][0], o[2][1], o[3][0], o[3][1]}, (f32x4*)(xo + c + 4)); }
                else { *(u32x4*)(xbo + c) = (u32x4){pk2(o[0][0], o[0][1]), pk2(o[1][0], o[1][1]), pk2(o[2][0], o[2][1]), pk2(o[3][0], o[3][1])};
                    if (ns == 1) *(u32x4*)(u + c) = (u32x4){pk2(m[0][0], m[0][1]), pk2(m[1][0], m[1][1]), pk2(m[2][0], m[2][1]), pk2(m[3][0], m[3][1])};
                    *(u32x2*)(u8 + c) = (u32x2){pk4_fp8(m[0][0], m[0][1], m[1][0], m[1][1]), pk4_fp8(m[2][0], m[2][1], m[3][0], m[3][1])}; } }
        }
    }
}
__device__ __forceinline__ void rope4(f32x4& v, int c, int t, const float* ropeT) {
    const int pos = (c >= 16) ? (t & 63) : (t >> 6), f0 = (2 * c) & 31;
    const f32x2 cs = *(const f32x2*)(ropeT + pos * 32 + f0), sn = *(const f32x2*)(ropeT + 2048 + pos * 32 + f0);
    const float x0 = v[0] * cs[0] - v[1] * sn[0], x1 = v[0] * sn[0] + v[1] * cs[0], x2 = v[2] * cs[1] - v[3] * sn[1], x3 = v[2] * sn[1] + v[3] * cs[1];
    v = (f32x4){x0, x1, x2, x3};
}
__device__ __forceinline__ void rope4_lds(f32x4& v, int c, int t, const LAS float* ropeT) {
    const int pos = (c >= 16) ? (t & 63) : (t >> 6), f0 = (2 * c) & 31;
    const f32x2 cs = *(const LAS f32x2*)(ropeT + pos * 32 + f0), sn = *(const LAS f32x2*)(ropeT + 2048 + pos * 32 + f0);
    const float x0 = v[0] * cs[0] - v[1] * sn[0], x1 = v[0] * sn[0] + v[1] * cs[0], x2 = v[2] * cs[1] - v[3] * sn[1], x3 = v[2] * sn[1] + v[3] * cs[1];
    v = (f32x4){x0, x1, x2, x3};
}
__device__ __forceinline__ void phase_prep(Frame& F, int l) {
    const int lane = F.lane, c32 = lane & 31;
    LAS float* WA = (LAS float*)F.lds; LAS float* BA = WA + 8192; LAS float* RT = BA + 512;
    for (int i = F.tid; i < 2048; i += 512) *(LAS f32x4*)(WA + 4 * i) = *(const f32x4*)(inp(I_WA2) + (size_t)l * 8192 + 4 * i);
    if (F.tid < 128) *(LAS f32x4*)(BA + 4 * F.tid) = *(const f32x4*)(inp(I_BA) + (size_t)l * 512 + 4 * F.tid);
    for (int i = F.tid; i < 1024; i += 512) *(LAS f32x4*)(RT + 4 * i) = *(const f32x4*)(F_ROPE + 4 * i);
    __syncthreads();
    const f32x4 qn = *(const f32x4*)(inp(I_QN) + l * 128 + 4 * c32), kn = *(const f32x4*)(inp(I_KN) + l * 128 + 4 * c32);
    for (int row = F.gw; row < MT + 512; row += F.ngw) {
        if (row >= MT) {
            const int r = row - MT, b = r >> 8, t = r & 255;
            const size_t src = ((size_t)((b * 2 + l) * 256 + t)) * 256 + 4 * lane, dst = KB_LAT_OFF + ((size_t)(b * LSEQ + t)) * 256 + 4 * lane;
            const f32x4 kv = *(const f32x4*)(inp(I_CK) + src), vv = *(const f32x4*)(inp(I_CV) + src);
            *(u32x2*)(F_KB + dst) = (u32x2){pk2(kv[0], kv[1]), pk2(kv[2], kv[3])};
            *(u32x2*)(F_VB + dst) = (u32x2){pk2(vv[0], vv[1]), pk2(vv[2], vv[3])};
            continue;
        }
        const bool lat = row >= M_CTX; const int t = (row - M_CTX) & 4095;
        const bf16_t* p = F_PROJ + (size_t)row * NPROJP;
        u32x2 aqw[4]; f32x4 gaw[8];
#pragma unroll
        for (int j = 0; j < 4; ++j) aqw[j] = *(const u32x2*)(p + C_AQ + 256 * j + 4 * lane);
        const u32x2 akw = *(const u32x2*)(p + C_AK + 4 * lane), avw = *(const u32x2*)(p + C_AV + 4 * lane);
        { const float* gp = F_GA + (size_t)row * 32;
#pragma unroll
          for (int i = 0; i < 8; ++i) gaw[i] = *(const f32x4*)(gp + 4 * i); }
#pragma unroll
        for (int j = 0; j < 4; ++j) {
            f32x4 x = bf4_to_f32(aqw[j]);
            const float ss = half_sum32((x[0] * x[0] + x[1] * x[1]) + (x[2] * x[2] + x[3] * x[3]));
            const float rs = 1.0f / sqrtf(ss * (1.0f / 128.0f) + RMS_EPS);
            x = x * rs * qn;
            if (lat) rope4_lds(x, c32, t, RT);
            *(u32x2*)(F_QB + (size_t)row * 1024 + 256 * j + 4 * lane) = (u32x2){pk2(x[0], x[1]), pk2(x[2], x[3])};
        }
        size_t kvdst; if (lat) { const int b = (row - M_CTX) >> 12; kvdst = KB_LAT_OFF + ((size_t)(b * LSEQ + 256 + t)) * 256 + 4 * lane; } else kvdst = (size_t)row * 256 + 4 * lane;
        {
            f32x4 x = bf4_to_f32(akw);
            const float ss = half_sum32((x[0] * x[0] + x[1] * x[1]) + (x[2] * x[2] + x[3] * x[3]));
            const float rs = 1.0f / sqrtf(ss * (1.0f / 128.0f) + RMS_EPS);
            x = x * rs * kn;
            if (lat) rope4_lds(x, c32, t, RT);
            *(u32x2*)(F_KB + kvdst) = (u32x2){pk2(x[0], x[1]), pk2(x[2], x[3])};
            if (!lat) { const int b = row >> 8, tt = row & 255; __builtin_nontemporal_store(x, (f32x4*)(F.out + O_K + ((size_t)((b * 2 + l) * 256 + tt)) * 256 + 4 * lane)); }
        }
        {
            *(u32x2*)(F_VB + kvdst) = avw;
            if (!lat) { const int b = row >> 8, tt = row & 255; __builtin_nontemporal_store(bf4_to_f32(avw), (f32x4*)(F.out + O_V + ((size_t)((b * 2 + l) * 256 + tt)) * 256 + 4 * lane)); }
        }
        {
#pragma unroll
            for (int d = 0; d < 2; ++d) {
                f32x4 pre = *(const LAS f32x4*)(BA + d * 256 + 4 * lane);
                const LAS float* w = WA + d * 4096 + 4 * lane;
#pragma unroll
                for (int r = 0; r < 16; ++r) pre = pre + *(const LAS f32x4*)(w + r * 256) * gaw[(16 * d + r) >> 2][(16 * d + r) & 3];
                f32x4 la;
#pragma unroll
                for (int e = 0; e < 4; ++e) { const float x = pre[e]; la[e] = (fminf(x, 0.f) - __logf(1.0f + __expf(-fabsf(x)))) * (1.0f / 16.0f); }
                *(f32x4*)(F_LA + (size_t)row * 512 + d * 256 + 4 * lane) = la;
            }
        }
    }
}

__device__ __forceinline__ void ret_l1_unit(Frame& F, int l, int u) {
    const int tid = launder_v(F.tid), lane = tid & 63;
    const int cidx = u >> 2, h = u & 3, row0 = cidx * 128; const bool lat = cidx >= 32; const int t0 = (row0 - M_CTX) & 4095;
    LAS bf16_t* Kf = (LAS bf16_t*)F.lds; LAS bf16_t* Kb = Kf + 128 * 144; LAS bf16_t* Vs = Kb + 128 * 144;
    const float lgf = inp(I_RLD)[(l * 2 + 0) * 4 + h] * 1.44269504089f, lgb = inp(I_RLD)[(l * 2 + 1) * 4 + h] * 1.44269504089f;
    const bf16_t* kp = F_PROJ + (size_t)row0 * NPROJP + C_RK + h * 128;
    __syncthreads();
    u32x4 kr[4];
#pragma unroll
    for (int b = 0; b < 4; ++b) { const int idx = tid + 512 * b, r = idx >> 4, c = idx & 15; kr[b] = *(const u32x4*)(kp + (size_t)r * NPROJP + 8 * c); }
    stage_bf16<128, 128>(Vs, 144, F_PROJ + (size_t)row0 * NPROJP + C_RV + h * 128, NPROJP, tid);
#pragma unroll
    for (int b = 0; b < 4; ++b) { const int idx = tid + 512 * b, r = idx >> 4, c = idx & 15;
        float x[8]; bf8_to_f32(kr[b], x);
#pragma unroll
        for (int e = 0; e < 8; ++e) x[e] *= 0.08838834764831845f;
        if (lat) rope8(x, c, t0 + r, F_ROPE);
        const float wf = __builtin_amdgcn_exp2f(lgf * (float)(127 - r)), wb = __builtin_amdgcn_exp2f(lgb * (float)r);
        float xf[8], xb[8];
#pragma unroll
        for (int e = 0; e < 8; ++e) { xf[e] = x[e] * wf; xb[e] = x[e] * wb; }
        *(LAS u32x4*)(Kf + r * 144 + 8 * c) = f32_to_bf8(xf); *(LAS u32x4*)(Kb + r * 144 + 8 * c) = f32_to_bf8(xb); }
    __syncthreads();
    const int w = tid >> 6, d0 = 32 * (w >> 1), e0 = 64 * (w & 1), li = lane & 15, lk = lane >> 4;
    f32x4 af[2][4], ab[2][4]; zero_acc(af); zero_acc(ab);
    mmb<2, 4, true, true>(af, Kf, 144, d0, Vs, 144, e0, 128, lane);
    mmb<2, 4, true, true>(ab, Kb, 144, d0, Vs, 144, e0, 128, lane);
    float* of = F_RKV + (size_t)(u * 2) * 16384; float* ob = of + 16384;
#pragma unroll
    for (int tm = 0; tm < 2; ++tm)
#pragma unroll
        for (int tn = 0; tn < 4; ++tn) { const int d = d0 + 16 * tm + li, e = e0 + 16 * tn + 4 * lk; *(f32x4*)(of + d * 128 + e) = af[tm][tn]; *(f32x4*)(ob + d * 128 + e) = ab[tm][tn]; }
}
__device__ __forceinline__ void gla_cumsum(LAS float* LAf, LAS float* LAb, int tid) {
    const int w = tid >> 6, lane = tid & 63;
    for (int s0 = w; s0 < 128; s0 += 32) {
        LAS float* p[4]; float v[4];
#pragma unroll
        for (int q = 0; q < 4; ++q) { const int s = s0 + 8 * q; const bool bwd = s >= 64; const int d = s & 63, j = bwd ? 63 - lane : lane; p[q] = (bwd ? LAb : LAf) + j * 66 + d; v[q] = *p[q]; }
#pragma unroll
        for (int q = 0; q < 4; ++q) v[q] = wave_prefix(v[q]);
#pragma unroll
        for (int q = 0; q < 4; ++q) *p[q] = v[q];
    }
}
__device__ __forceinline__ void gla_l1_unit(Frame& F, int l, int u) {
    const int tid = launder_v(F.tid), lane = tid & 63;
    const int cg = u >> 2, h = u & 3, row0 = cg * 64;
    LAS float* LAf = (LAS float*)F.lds; LAS float* LAb = LAf + 64 * 66;
    LAS bf16_t* Kf = (LAS bf16_t*)(LAb + 64 * 66); LAS bf16_t* Kb = Kf + 64 * 80; LAS bf16_t* Vs = Kb + 64 * 80;
    __syncthreads();
    const int kr_r = tid >> 3, kr_c = tid & 7;
    const u32x4 kr = *(const u32x4*)(F_PROJ + (size_t)(row0 + kr_r) * NPROJP + C_GK + h * 64 + 8 * kr_c);
    stage_f32<64, 64>(LAf, 66, F_LA + (size_t)row0 * 512 + h * 64, 512, tid);
    stage_f32<64, 64>(LAb, 66, F_LA + (size_t)row0 * 512 + 256 + h * 64, 512, tid);
    stage_bf16<64, 128>(Vs, 144, F_PROJ + (size_t)row0 * NPROJP + C_GV + h * 128, NPROJP, tid);
    __syncthreads();
    gla_cumsum(LAf, LAb, tid);
    __syncthreads();
#pragma unroll
    for (int b = 0; b < 2; ++b) { const int idx = tid + 512 * b, r = idx >> 4, c = idx & 15;
        float* g = F_LA + (size_t)(row0 + r) * 512 + h * 64 + 4 * c; const LAS float* sf = LAf + r * 66 + 4 * c; const LAS float* sb = LAb + r * 66 + 4 * c;
        *(f32x4*)g = (f32x4){sf[0], sf[1], sf[2], sf[3]}; *(f32x4*)(g + 256) = (f32x4){sb[0], sb[1], sb[2], sb[3]}; }
    { float x[8], xf[8], xb[8]; bf8_to_f32(kr, x);
#pragma unroll
      for (int e = 0; e < 8; ++e) { const int d = 8 * kr_c + e; xf[e] = x[e] * __expf(LAf[63 * 66 + d] - LAf[kr_r * 66 + d]); xb[e] = x[e] * __expf(LAb[d] - LAb[kr_r * 66 + d]); }
      *(LAS u32x4*)(Kf + kr_r * 80 + 8 * kr_c) = f32_to_bf8(xf); *(LAS u32x4*)(Kb + kr_r * 80 + 8 * kr_c) = f32_to_bf8(xb); }
    if (tid < 64) { F_GDEC[(size_t)(u * 2) * 64 + tid] = __expf(LAf[63 * 66 + tid]); F_GDEC[(size_t)(u * 2 + 1) * 64 + tid] = __expf(LAb[tid]); }
    __syncthreads();
    const int w = tid >> 6, d0 = 16 * (w >> 1), e0 = 64 * (w & 1), li = lane & 15, lk = lane >> 4;
    f32x4 af[1][4], ab[1][4]; zero_acc(af); zero_acc(ab);
    mmb<1, 4, true, true>(af, Kf, 80, d0, Vs, 144, e0, 64, lane);
    mmb<1, 4, true, true>(ab, Kb, 80, d0, Vs, 144, e0, 64, lane);
    float* of = F_GKV + (size_t)(u * 2) * 8192; float* ob = of + 8192;
#pragma unroll
    for (int tn = 0; tn < 4; ++tn) { const int d = d0 + li, e = e0 + 16 * tn + 4 * lk; *(f32x4*)(of + d * 128 + e) = af[0][tn]; *(f32x4*)(ob + d * 128 + e) = ab[0][tn]; }
}
template <int N, int ESZ, bool GLA>
__device__ __forceinline__ f32x4 scan_chain(f32x4 S, const float* KV, bf16_t* SP, const float* DEC, int c0, int h, int dir, int q4, float dec0) {
    constexpr int B = N < 16 ? N : 16;
    for (int st = 0; st < N; st += B) {
        f32x4 kv[B]; float dc[B]; size_t off[B];
#pragma unroll
        for (int q = 0; q < B; ++q) { const int c = dir ? N - 1 - (st + q) : st + q; const int uu = (c0 + c) * 4 + h; off[q] = ((size_t)(uu * 2 + dir)) * ESZ + 4 * q4;
            kv[q] = *(const f32x4*)(KV + off[q]); dc[q] = GLA ? DEC[(size_t)(uu * 2 + dir) * 64 + (q4 >> 5)] : dec0; }
#pragma unroll
        for (int q = 0; q < B; ++q) { *(u32x2*)(SP + off[q]) = (u32x2){pk2(S[0], S[1]), pk2(S[2], S[3])}; S = S * dc[q] + kv[q]; }
    }
    return S;
}
__device__ __forceinline__ void scan_ret_item(Frame& F, int l, int it) {
    const bool lat = it < 65536; const int it2 = lat ? it : it - 65536;
    const int chain = it2 >> 12, q4 = it2 & 4095, b = chain >> 3, h = (chain >> 1) & 3, dir = chain & 1;
    const size_t sidx = ((size_t)(((b * 2 + l) * 2 + dir) * 4 + h)) * 16384 + 4 * q4;
    const float dec = __expf(128.0f * inp(I_RLD)[(l * 2 + dir) * 4 + h]);
    if (lat) { (void)scan_chain<32, 16384, false>(*(const f32x4*)(inp(I_SR) + sidx), F_RKV, F_RSP, nullptr, 32 + 32 * b, h, dir, q4, dec); }
    else { const f32x4 S = scan_chain<2, 16384, false>((f32x4){0.f, 0.f, 0.f, 0.f}, F_RKV, F_RSP, nullptr, 2 * b, h, dir, q4, dec); __builtin_nontemporal_store(S, (f32x4*)(F.out + O_SR + sidx)); }
}
__device__ __forceinline__ void scan_gla_item(Frame& F, int l, int it) {
    const bool lat = it < 32768; const int it2 = lat ? it : it - 32768;
    const int chain = it2 >> 11, q4 = it2 & 2047, b = chain >> 3, h = (chain >> 1) & 3, dir = chain & 1;
    const size_t sidx = ((size_t)(((b * 2 + l) * 2 + dir) * 4 + h)) * 8192 + 4 * q4;
    if (lat) { (void)scan_chain<64, 8192, true>(*(const f32x4*)(inp(I_SG) + sidx), F_GKV, F_GSP, F_GDEC, 64 + 64 * b, h, dir, q4, 0.f); }
    else { const f32x4 S = scan_chain<4, 8192, true>((f32x4){0.f, 0.f, 0.f, 0.f}, F_GKV, F_GSP, F_GDEC, 4 * b, h, dir, q4, 0.f); __builtin_nontemporal_store(S, (f32x4*)(F.out + O_SG + sidx)); }
}
template <int N, int ESZ, bool GLA, int NI, int SHIFT>
__device__ __forceinline__ void scan_ctx_batch(Frame& F, int l, int it2_0, int it2_step, const float* KV, bf16_t* SP, const float* DEC, float* OUT) {
    f32x4 kv[NI][N]; float dc[NI][N];
#pragma unroll
    for (int k = 0; k < NI; ++k) { const int it2 = it2_0 + k * it2_step, chain = it2 >> SHIFT, q4 = it2 & ((1 << SHIFT) - 1), b = chain >> 3, h = (chain >> 1) & 3, dir = chain & 1;
#pragma unroll
        for (int c = 0; c < N; ++c) { const int cc = dir ? N - 1 - c : c; const int uu = (N * b + cc) * 4 + h; const size_t off = ((size_t)(uu * 2 + dir)) * ESZ + 4 * q4;
            kv[k][c] = *(const f32x4*)(KV + off); dc[k][c] = GLA ? DEC[(size_t)(uu * 2 + dir) * 64 + (q4 >> 5)] : (c == 0 ? inp(I_RLD)[(l * 2 + dir) * 4 + h] : 0.f); } }
    const float z = __builtin_bit_cast(float, launder_v(0));
#pragma unroll
    for (int k = 0; k < NI; ++k) { const int it2 = it2_0 + k * it2_step, chain = it2 >> SHIFT, q4 = it2 & ((1 << SHIFT) - 1), b = chain >> 3, h = (chain >> 1) & 3, dir = chain & 1;
        const float dec0 = GLA ? 0.f : __expf(128.0f * dc[k][0]);
        f32x4 S = {z, z, z, z};
#pragma unroll
        for (int c = 0; c < N; ++c) { const int cc = dir ? N - 1 - c : c; const int uu = (N * b + cc) * 4 + h; const size_t off = ((size_t)(uu * 2 + dir)) * ESZ + 4 * q4;
            *(u32x2*)(SP + off) = (u32x2){pk2(S[0], S[1]), pk2(S[2], S[3])}; S = S * (GLA ? dc[k][c] : dec0) + kv[k][c]; }
        __builtin_nontemporal_store(S, (f32x4*)(OUT + ((size_t)(((b * 2 + l) * 2 + dir) * 4 + h)) * ESZ + 4 * q4)); }
}
__device__ __forceinline__ void phase_scan(Frame& F, int l) {
    const int gt = F.vcu * 512 + F.tid, NT = F.G * 512;
    if (NT == 131072) {
        if (gt < 65536) { scan_ret_item(F, l, gt); scan_ctx_batch<2, 16384, false, 8, 12>(F, l, gt, 65536, F_RKV, F_RSP, nullptr, F.out + O_SR); }
        else if (gt < 98304) scan_gla_item(F, l, gt - 65536);
        else { const int g2 = gt - 98304; scan_ctx_batch<4, 8192, true, 4, 11>(F, l, g2, 32768, F_GKV, F_GSP, F_GDEC, F.out + O_SG); scan_ctx_batch<4, 8192, true, 4, 11>(F, l, g2 + 4 * 32768, 32768, F_GKV, F_GSP, F_GDEC, F.out + O_SG); }
    } else {
        for (int it = gt; it < 589824; it += NT) scan_ret_item(F, l, it);
        for (int it = gt; it < 294912; it += NT) scan_gla_item(F, l, it);
    }
}
__device__ __forceinline__ void ret_l3_unit(Frame& F, int l, int u) {
    const int tid = launder_v(F.tid), lane = tid & 63;
    const int cidx = u >> 2, h = u & 3, row0 = cidx * 128; const bool lat = cidx >= 32; const int t0 = (row0 - M_CTX) & 4095;
    LAS bf16_t* Qs = (LAS bf16_t*)F.lds; LAS bf16_t* Ks = Qs + 128 * 136; LAS bf16_t* SfV = Ks + 128 * 136; LAS bf16_t* Sbs = SfV + 128 * 144;
    LAS float* RED = (LAS float*)(F.lds + LDS_RED);
    const float lgf = inp(I_RLD)[(l * 2 + 0) * 4 + h] * 1.44269504089f, lgb = inp(I_RLD)[(l * 2 + 1) * 4 + h] * 1.44269504089f;
    const int w = tid >> 6, i0 = 32 * (w >> 1), e0 = 64 * (w & 1), wcol = w & 1, li = lane & 15, lk = lane >> 4;
    const bf16_t* pb = F_PROJ + (size_t)row0 * NPROJP + h * 128;
    __syncthreads();
    u32x2 gr[2][4];
    {
        u32x4 qr[4], kr[4];
#pragma unroll
        for (int b = 0; b < 4; ++b) { const int idx = tid + 512 * b, r = idx >> 4, c = idx & 15; qr[b] = *(const u32x4*)(pb + C_RQ + (size_t)r * NPROJP + 8 * c); kr[b] = *(const u32x4*)(pb + C_RK + (size_t)r * NPROJP + 8 * c); }
        stage_bf16<128, 128>(SfV, 144, F_RSP + (size_t)(u * 2) * 16384, 128, tid);
        stage_bf16<128, 128>(Sbs, 144, F_RSP + (size_t)(u * 2 + 1) * 16384, 128, tid);
#pragma unroll
        for (int tm = 0; tm < 2; ++tm)
#pragma unroll
            for (int tn = 0; tn < 4; ++tn) gr[tm][tn] = *(const u32x2*)(pb + (size_t)(i0 + 16 * tm + li) * NPROJP + C_RG + e0 + 16 * tn + 4 * lk);
#pragma unroll
        for (int b = 0; b < 4; ++b) { const int idx = tid + 512 * b, r = idx >> 4, c = idx & 15;
            float x[8]; bf8_to_f32(qr[b], x); if (lat) rope8(x, c, t0 + r, F_ROPE); *(LAS u32x4*)(Qs + r * 136 + 8 * c) = f32_to_bf8(x);
            bf8_to_f32(kr[b], x);
#pragma unroll
            for (int e = 0; e < 8; ++e) x[e] *= 0.08838834764831845f;
            if (lat) rope8(x, c, t0 + r, F_ROPE); *(LAS u32x4*)(Ks + r * 136 + 8 * c) = f32_to_bf8(x); }
    }
    __syncthreads();
    f32x4 out[2][4], tmp[2][4];
    zero_acc(out); mmb<2, 4, false, true>(out, Qs, 136, i0, SfV, 144, e0, 128, lane);
#pragma unroll
    for (int tm = 0; tm < 2; ++tm) { const float f = __builtin_amdgcn_exp2f(lgf * (float)(i0 + 16 * tm + li + 1));
#pragma unroll
        for (int tn = 0; tn < 4; ++tn) out[tm][tn] = out[tm][tn] * f; }
    zero_acc(tmp); mmb<2, 4, false, true>(tmp, Qs, 136, i0, Sbs, 144, e0, 128, lane);
#pragma unroll
    for (int tm = 0; tm < 2; ++tm) { const float f = __builtin_amdgcn_exp2f(lgb * (float)(128 - (i0 + 16 * tm + li)));
#pragma unroll
        for (int tn = 0; tn < 4; ++tn) out[tm][tn] = out[tm][tn] + tmp[tm][tn] * f; }
    zero_acc(tmp); mmb<2, 4, false, false>(tmp, Qs, 136, i0, Ks, 136, e0, 128, lane);
    u32x4 vr[4];
#pragma unroll
    for (int b = 0; b < 4; ++b) { const int idx = tid + 512 * b, r = idx >> 4, c = idx & 15; vr[b] = *(const u32x4*)(pb + C_RV + (size_t)r * NPROJP + 8 * c); }
    __syncthreads();
#pragma unroll
    for (int tm = 0; tm < 2; ++tm)
#pragma unroll
        for (int tn = 0; tn < 4; ++tn) { const int i = i0 + 16 * tm + li, jb = e0 + 16 * tn + 4 * lk; float pv[4];
#pragma unroll
            for (int r = 0; r < 4; ++r) { const int df = i - (jb + r);
                const float dm = df > 0 ? __builtin_amdgcn_exp2f(lgf * (float)df) : (df < 0 ? __builtin_amdgcn_exp2f(lgb * (float)(-df)) : 2.0f);
                pv[r] = tmp[tm][tn][r] * dm; }
            *(LAS u32x2*)(Ks + i * 136 + jb) = (u32x2){pk2(pv[0], pv[1]), pk2(pv[2], pv[3])}; }
#pragma unroll
    for (int b = 0; b < 4; ++b) { const int idx = tid + 512 * b, r = idx >> 4, c = idx & 15; *(LAS u32x4*)(SfV + r * 144 + 8 * c) = vr[b]; }
    __syncthreads();
    mmb<2, 4, false, true>(out, Ks, 136, i0, SfV, 144, e0, 128, lane);
    float mu[2], rs[2];
#pragma unroll
    for (int tm = 0; tm < 2; ++tm) { float s = 0.f;
#pragma unroll
        for (int tn = 0; tn < 4; ++tn) s += (out[tm][tn][0] + out[tm][tn][1]) + (out[tm][tn][2] + out[tm][tn][3]);
        s += shflx(s, 16); s += shflx(s, 32);
        if (lk == 0) RED[(i0 + 16 * tm + li) * 2 + wcol] = s; }
    __syncthreads();
#pragma unroll
    for (int tm = 0; tm < 2; ++tm) { const int i = i0 + 16 * tm + li; mu[tm] = (RED[i * 2] + RED[i * 2 + 1]) * (1.0f / 128.0f); }
    __syncthreads();
#pragma unroll
    for (int tm = 0; tm < 2; ++tm) { float q = 0.f;
#pragma unroll
        for (int tn = 0; tn < 4; ++tn)
#pragma unroll
            for (int r = 0; r < 4; ++r) { const float dd = out[tm][tn][r] - mu[tm]; q += dd * dd; }
        q += shflx(q, 16); q += shflx(q, 32);
        if (lk == 0) RED[(i0 + 16 * tm + li) * 2 + wcol] = q; }
    __syncthreads();
#pragma unroll
    for (int tm = 0; tm < 2; ++tm) { const int i = i0 + 16 * tm + li; rs[tm] = 1.0f / sqrtf((RED[i * 2] + RED[i * 2 + 1]) * (1.0f / 128.0f) + LN_EPS); }
#pragma unroll
    for (int tm = 0; tm < 2; ++tm) { const size_t row = (size_t)(row0 + i0 + 16 * tm + li);
#pragma unroll
        for (int tn = 0; tn < 4; ++tn) { const int e = e0 + 16 * tn + 4 * lk; const f32x4 g = bf4_to_f32(gr[tm][tn]);
            const f32x4 o = out[tm][tn];
            const float rq = rs[tm] * S8_MA;
            *(unsigned*)(F_MA8 + row * 2048 + 1024 + h * 128 + e) = pk4_fp8((o[0] - mu[tm]) * rq * siluf(g[0]), (o[1] - mu[tm]) * rq * siluf(g[1]), (o[2] - mu[tm]) * rq * siluf(g[2]), (o[3] - mu[tm]) * rq * siluf(g[3])); } }
}
__device__ __forceinline__ void gla_l3_unit(Frame& F, int l, int u) {
    const int tid = launder_v(F.tid), lane = tid & 63;
    const int cg = u >> 2, h = u & 3, row0 = cg * 64;
    LAS float* LAf = (LAS float*)F.lds; LAS float* LAb = LAf + 64 * 66;
    LAS bf16_t* Qf = (LAS bf16_t*)(LAb + 64 * 66); LAS bf16_t* Qb = Qf + 64 * 72; LAS bf16_t* Kf = Qb + 64 * 72; LAS bf16_t* Kb = Kf + 64 * 72;
    LAS bf16_t* Sfs = Kb + 64 * 72; LAS bf16_t* Sbs = Sfs + 64 * 144; LAS bf16_t* Vs = Sbs + 64 * 144; LAS bf16_t* Ps = Vs + 64 * 144;
    LAS float* RED = (LAS float*)(F.lds + LDS_RED);
    const int w = tid >> 6, i0 = 16 * (w >> 1), e0 = 64 * (w & 1), j0 = 32 * (w & 1), wcol = w & 1, li = lane & 15, lk = lane >> 4;
    const bf16_t* pb = F_PROJ + (size_t)row0 * NPROJP;
    __syncthreads();
    const int cr = tid >> 3, cc = tid & 7;
    const u32x4 qr = *(const u32x4*)(pb + (size_t)cr * NPROJP + C_GQ + h * 64 + 8 * cc), kr = *(const u32x4*)(pb + (size_t)cr * NPROJP + C_GK + h * 64 + 8 * cc);
    stage_f32<64, 64>(LAf, 66, F_LA + (size_t)row0 * 512 + h * 64, 512, tid);
    stage_f32<64, 64>(LAb, 66, F_LA + (size_t)row0 * 512 + 256 + h * 64, 512, tid);
    stage_bf16<64, 128>(Sfs, 144, F_GSP + (size_t)(u * 2) * 8192, 128, tid);
    stage_bf16<64, 128>(Sbs, 144, F_GSP + (size_t)(u * 2 + 1) * 8192, 128, tid);
    stage_bf16<64, 128>(Vs, 144, pb + C_GV + h * 128, NPROJP, tid);
    u32x2 gg[4]; f32x4 gnv[4];
#pragma unroll
    for (int tn = 0; tn < 4; ++tn) { const int e = e0 + 16 * tn + 4 * lk; gg[tn] = *(const u32x2*)(pb + (size_t)(i0 + li) * NPROJP + C_GR + h * 128 + e); gnv[tn] = *(const f32x4*)(inp(I_GN) + l * 128 + e); }
    __syncthreads();
    { float q[8], k[8], a[8], b[8], c[8], d[8]; bf8_to_f32(qr, q); bf8_to_f32(kr, k);
#pragma unroll
      for (int e = 0; e < 8; ++e) { const float bf = LAf[cr * 66 + 8 * cc + e], bb = LAb[cr * 66 + 8 * cc + e]; const float qs = q[e] * 0.125f;
          a[e] = qs * __expf(bf); b[e] = qs * __expf(bb); c[e] = k[e] * __expf(-bf); d[e] = k[e] * __expf(-bb); }
      *(LAS u32x4*)(Qf + cr * 72 + 8 * cc) = f32_to_bf8(a); *(LAS u32x4*)(Qb + cr * 72 + 8 * cc) = f32_to_bf8(b);
      *(LAS u32x4*)(Kf + cr * 72 + 8 * cc) = f32_to_bf8(c); *(LAS u32x4*)(Kb + cr * 72 + 8 * cc) = f32_to_bf8(d); }
    __syncthreads();
    f32x4 out[1][4], sf[1][2], sb[1][2];
    zero_acc(out); zero_acc(sf); zero_acc(sb);
    mmb<1, 4, false, true>(out, Qf, 72, i0, Sfs, 144, e0, 64, lane);
    mmb<1, 4, false, true>(out, Qb, 72, i0, Sbs, 144, e0, 64, lane);
    mmb<1, 2, false, false>(sf, Qf, 72, i0, Kf, 72, j0, 64, lane);
    mmb<1, 2, false, false>(sb, Qb, 72, i0, Kb, 72, j0, 64, lane);
#pragma unroll
    for (int tn = 0; tn < 2; ++tn) { const int i = i0 + li, jb = j0 + 16 * tn + 4 * lk; float pv[4];
#pragma unroll
        for (int r = 0; r < 4; ++r) { const int j = jb + r; pv[r] = (j <= i ? sf[0][tn][r] : 0.f) + (j >= i ? sb[0][tn][r] : 0.f); }
        *(LAS u32x2*)(Ps + i * 72 + jb) = (u32x2){pk2(pv[0], pv[1]), pk2(pv[2], pv[3])}; }
    __syncthreads();
    mmb<1, 4, false, true>(out, Ps, 72, i0, Vs, 144, e0, 64, lane);
    { float q = 0.f;
#pragma unroll
      for (int tn = 0; tn < 4; ++tn)
#pragma unroll
          for (int r = 0; r < 4; ++r) q += out[0][tn][r] * out[0][tn][r];
      q += shflx(q, 16); q += shflx(q, 32);
      if (lk == 0) RED[(i0 + li) * 2 + wcol] = q; }
    __syncthreads();
    const float rs = 1.0f / sqrtf((RED[(i0 + li) * 2] + RED[(i0 + li) * 2 + 1]) * (1.0f / 128.0f) + RMS_EPS);
    const size_t row = (size_t)(row0 + i0 + li);
#pragma unroll
    for (int tn = 0; tn < 4; ++tn) { const int e = e0 + 16 * tn + 4 * lk; const f32x4 g = bf4_to_f32(gg[tn]);
        const f32x4 gn = gnv[tn]; const f32x4 o = out[0][tn];
        const float rq = rs * S8_MA;
        *(unsigned*)(F_MA8 + row * 2048 + 1536 + h * 128 + e) = pk4_fp8(o[0] * rq * gn[0] * siluf(g[0]), o[1] * rq * gn[1] * siluf(g[1]), o[2] * rq * gn[2] * siluf(g[2]), o[3] * rq * gn[3] * siluf(g[3])); }
}
__device__ __forceinline__ void attn_any_unit(Frame& F, int c) {
    size_t qrow, kvoff; int h, kvh, seq;
    if (c < 256) { const int x = c & 7, idx = c >> 3, combo = x >> 1, sub = (x & 1) * 32 + idx, g = sub >> 4, qb = sub & 15, b = combo >> 1; kvh = combo & 1; h = kvh * 4 + g;
        qrow = (size_t)(M_CTX + b * 4096 + qb * 256); kvoff = KB_LAT_OFF + (size_t)b * LSEQ * 256; seq = LSEQ; }
    else { const int cc = c - 256, b = cc >> 3; h = cc & 7; kvh = h >> 2; qrow = (size_t)b * 256; kvoff = qrow * 256; seq = 256; }
    __syncthreads();
    att::attn_unit(F_QB + qrow * 1024 + h * 128, F_KB + kvoff + kvh * 128, F_VB + kvoff + kvh * 128, F_MA8 + qrow * 2048 + h * 128, seq, (char*)F.lds, launder_v(F.tid));
}

constexpr int N_PHASES = 2 + 13 * DEPTH;
__global__ void __launch_bounds__(512, 2) mk_fwd(Args args) {
    extern __shared__ __attribute__((aligned(16))) unsigned char lds_raw[];
    asm volatile("s_nop 0\n\ts_nop 0");
    Frame F;
    F.lds = (LAS unsigned char*)lds_raw;
    F.tid = threadIdx.x; F.lane = 0; F.wave = __builtin_amdgcn_readfirstlane((int)threadIdx.x >> 6); F.G = 0; F.vcu = 0; F.gw = 0; F.ngw = 0; F.bx = 0;
    F.out = (float*)(GAS float*)args.out; F.ws = (unsigned char*)(GAS unsigned char*)args.ws;
    unsigned char* ws = args.ws;
    volatile LAS unsigned* MISC = (volatile LAS unsigned*)(F.lds + LDS_MISC);
    if (F.tid < 64) MISC[F.tid] = 0u;
    __syncthreads();
    const int lo = args.ph_lo, hi = args.ph_hi;
    unsigned* barw = (unsigned*)(ws + WS_CTL) + CW_BAR;
    XcdBarrier bar; bar.bar = barw; bar.x = 0; bar.st = MISC + 8; bar.lead = (F.wave == 0);
    if (hi - lo > 1) bar = xcd_barrier_post(barw, MISC + 8, F.wave == 0);
#ifndef PROBE_DUP
#define PROBE_DUP 0
#endif
#define DUP(bit, ...) do { __VA_ARGS__; if ((PROBE_DUP >> (bit)) & 1) { __syncthreads(); __VA_ARGS__; } } while (0)
#define IN(k) (lo <= (k) && (k) < hi)
#define SEAM(k) do { if ((k) + 1 < hi) xcd_barrier(bar); } while (0)
    if (IN(0)) { DUP(0, { FRESH(P); phase_prologue_a(P); }); SEAM(0); }
    if (IN(1)) { FRESH(P); phase_modulate0(P); SEAM(1); }
    for (int l = 0; l < DEPTH; ++l) {
        const int p0 = 2 + 13 * l;
#define GEMM_SITE(F8_, Ap, Bp, lda_, nt_, nN_, KS_, ...) do { FRESH(P); { Frame& F = P; pg8::Gemm g{(const bf16_t*)(Ap), (const bf16_t*)(Bp), lda_, lda_, nt_}; pg8::Order S; S.init(48, nN_, KS_, P.G, P.bx); __VA_ARGS__; pg8::gemm_phase<F8_>(P.lds, g, S, E, P.tid); } } while (0)
        if (IN(p0 + 0)) { DUP(1, GEMM_SITE(true, F_U8, F_WIN8 + (size_t)(l * 2 + 0) * 11264 * 2048, DM / 2, 16, 44, 1, pg8::EpiSwiGLU8 E{F_H8, DFF}));
            { FRESH(P); if (P.bx >= 64) { const int wk = (P.bx - 64) * 8 + P.wave, nw = (P.G - 64) * 8;
                if (l == 0) convert_ranges(P, CV_OUT, CV_OUT + 5632, CV_MI, CV_MI + 5152, CV_MO, CV_MO + 2048, wk, nw);
                else convert_ranges(P, CV_OUT + 2 * 5632, CV_OUT + 3 * 5632, CV_PRO_END, CV_OUT, 0, 0, wk, nw); } }
            SEAM(p0 + 0); }
        if (IN(p0 + 1)) { DUP(2, GEMM_SITE(true, F_H8, F_WOUT8 + (size_t)(l * 2 + 0) * 2048 * 5632, DFF / 2, 22, 8, 2, pg8::EpiFp8 E{F_Y8, DM, (size_t)MT * DM, S8_Y / (S8_H * S8_WOUT)})); SEAM(p0 + 1); }
        if (IN(p0 + 2)) { FRESH(P); phase_post(P, l, 0, 0.5f, l == 0, l, 1); SEAM(p0 + 2); }
        if (IN(p0 + 3)) {
            DUP(3, { GEMM_SITE(false, F_U, F_WMI16 + (size_t)l * 10 * 256 * 2048, DM, 32, 10, 1, pg8::EpiProj E{F_PROJ, NPROJP, F_GA, MI_B16TBL, 1.0f});
                     do { FRESH(P); { Frame& F = P; pg8::Gemm g{(const bf16_t*)F_U8, (const bf16_t*)(F_WMI8 + (size_t)l * 11 * 256 * 2048), DM / 2, DM / 2, 16}; pg8::Order S; S.init(48, 11, 1, P.G, (P.bx + 32) % P.G);
                         pg8::EpiProj E{F_PROJ, NPROJP, F_GA, MI_F8TBL, 1.0f / S8_WMI}; pg8::gemm_phase<true>(P.lds, g, S, E, P.tid); } } while (0); });
            SEAM(p0 + 3); }
        if (IN(p0 + 4)) { DUP(4, { FRESH(P); phase_prep(P, l); }); DUP(5, { FRESH(P); for (int u = P.vcu; u < 384; u += P.G) ret_l1_unit(P, l, u); }); SEAM(p0 + 4); }
        if (IN(p0 + 5)) { DUP(6, { FRESH(P); for (int c = P.bx; c < 384; c += P.G) attn_any_unit(P, c); });
                          DUP(7, { FRESH(P); for (int u = P.vcu; u < 768; u += P.G) gla_l1_unit(P, l, u); }); SEAM(p0 + 5); }
        if (IN(p0 + 6)) { DUP(13, { FRESH(P); phase_scan(P, l); }); SEAM(p0 + 6); }
        if (IN(p0 + 7)) { DUP(8, { FRESH(P); for (int u = P.vcu; u < 384; u += P.G) ret_l3_unit(P, l, u); });
                          DUP(9, { FRESH(P); for (int u = P.vcu; u < 768; u += P.G) gla_l3_unit(P, l, u); }); SEAM(p0 + 7); }
        if (IN(p0 + 8)) { DUP(10, GEMM_SITE(true, F_MA8, F_WMO8 + (size_t)l * 2048 * 2048, DM / 2, 8, 8, 2, pg8::EpiFp8 E{F_Y8, DM, (size_t)MT * DM, S8_Y / (S8_MA * S8_WMO)})); SEAM(p0 + 8); }
        if (IN(p0 + 9)) { FRESH(P); phase_post(P, l, 1, 1.0f, false, l, 2); SEAM(p0 + 9); }
        if (IN(p0 + 10)) { DUP(1, GEMM_SITE(true, F_U8, F_WIN8 + (size_t)(l * 2 + 1) * 11264 * 2048, DM / 2, 16, 44, 1, pg8::EpiSwiGLU8 E{F_H8, DFF}));
            { FRESH(P); if (P.bx >= 64) { const int wk = (P.bx - 64) * 8 + P.wave, nw = (P.G - 64) * 8;
                if (l == 0) convert_ranges(P, CV_OUT + 5632, CV_OUT + 2 * 5632, CV_MI + 5152, CV_MO, CV_MO + 2048, CV_END, wk, nw);
                else convert_ranges(P, CV_OUT + 3 * 5632, CV_MI, 0, 0, 0, 0, wk, nw); } }
            SEAM(p0 + 10); }
        if (IN(p0 + 11)) { DUP(2, GEMM_SITE(true, F_H8, F_WOUT8 + (size_t)(l * 2 + 1) * 2048 * 5632, DFF / 2, 22, 8, 2, pg8::EpiFp8 E{F_Y8, DM, (size_t)MT * DM, S8_Y / (S8_H * S8_WOUT)})); SEAM(p0 + 11); }
        if (IN(p0 + 12)) { FRESH(P); phase_post(P, l, 2, 0.5f, false, l + 1, 0); SEAM(p0 + 12); }
    }
#undef IN
#undef SEAM
}

#ifndef MK_PER_PHASE
#define MK_PER_PHASE 0
#endif
extern "C" void kernel_launch(void* const* d_in, const int* in_sizes, int n_in, void* d_out, int out_size, void* d_ws, size_t ws_size, hipStream_t stream) {
    static int grid = 0;
    if (grid == 0) {
        if (n_in != N_IN || out_size != (int)O_END || ws_size < WS_END) { fprintf(stderr, "kernel_launch: shape mismatch (n_in %d out %d ws %zu, need %d %zu %zu)\n", n_in, out_size, ws_size, (int)N_IN, (size_t)O_END, (size_t)WS_END); grid = -1; return; }
        int dev = 0, cus = 0, per_cu = 0;
        if (hipGetDevice(&dev) != hipSuccess || hipDeviceGetAttribute(&cus, hipDeviceAttributeMultiprocessorCount, dev) != hipSuccess) { grid = -1; return; }
        if (hipFuncSetAttribute((const void*)mk_fwd, hipFuncAttributeMaxDynamicSharedMemorySize, LDS_BYTES) != hipSuccess) { fprintf(stderr, "kernel_launch: hipFuncSetAttribute(%d) failed\n", LDS_BYTES); grid = -1; return; }
        if (hipOccupancyMaxActiveBlocksPerMultiprocessor(&per_cu, (const void*)mk_fwd, 512, LDS_BYTES) != hipSuccess || per_cu < 1) fprintf(stderr, "kernel_launch: occupancy query reports %d\n", per_cu);
        (void)hipGetLastError();
        grid = cus;
    }
    if (grid < 0) return;
    if (hipMemsetAsync((char*)d_ws + WS_CTL, 0, CTL_ZERO_BYTES, stream) != hipSuccess) return;
    Args a{};
    for (int i = 0; i < N_IN; ++i) a.in[i] = (const float*)d_in[i];
    a.out = (float*)d_out; a.ws = (unsigned char*)d_ws;
#if MK_PER_PHASE
    for (int p = 0; p < N_PHASES; ++p) { a.ph_lo = p; a.ph_hi = p + 1; hipLaunchKernelGGL(mk_fwd, dim3(grid), dim3(512), LDS_BYTES, stream, a); }
#else
    a.ph_lo = 0; a.ph_hi = N_PHASES;
    hipLaunchKernelGGL(mk_fwd, dim3(grid), dim3(512), LDS_BYTES, stream, a);
#endif
    const hipError_t le = hipPeekAtLastError();
    if (le != hipSuccess) fprintf(stderr, "kernel_launch: launch failed: %s\n", hipGetErrorName(le));
}
```
